# Optimizing an MI355X kernel written in HIP

```python
import math
import jax, jax.numpy as jnp
from jax import lax
import numpy as np

D_MODEL = 2048
BATCH = 4
SEQ = 4096
DEPTH = 2

N_META = 16
BLOCK = 128
PAD = BLOCK - N_META
MIX_W = D_MODEL
GROUP_W = MIX_W // 4
SSM_W = GROUP_W
SSM_H = 16
SSM_G = SSM_W // SSM_H
SSM_P = 64
ML_HEADS = 4
ML_DH = GROUP_W // ML_HEADS
ML_CONV = 4
FX_HEADS = 4
FX_DH = GROUP_W // FX_HEADS
POOL_WINDOWS = (2, 4, 8, 16)
POOL_GW = GROUP_W // len(POOL_WINDOWS)
D_FF = 4 * D_MODEL
EPS = 1e-6
NEG = -1e30
IN_SPLIT = (SSM_W, GROUP_W, GROUP_W, GROUP_W, GROUP_W, ML_HEADS, ML_HEADS, GROUP_W, GROUP_W, GROUP_W, FX_HEADS, GROUP_W)
IN_COLS = sum(IN_SPLIT)

kernel_name = "hymba_s5_mlstm_fox_pool_hybrid"

F32 = jnp.float32


def rmsnorm(x, g):
    xf = x.astype(F32)
    y = xf * lax.rsqrt(jnp.mean(xf * xf, axis=-1, keepdims=True) + EPS)
    return (y * g.astype(F32)).astype(x.dtype)


def pad_front(a):
    return jnp.pad(a, [(0, 0), (PAD, 0)] + [(0, 0)] * (a.ndim - 2))


def causal_dwconv(x, w):
    k = w.shape[0]
    return lax.conv_general_dilated(x, w.astype(F32)[:, None, :], window_strides=(1,), padding=[(k - 1, 0)],
                                    dimension_numbers=('NWC', 'WIO', 'NWC'), feature_group_count=x.shape[-1])


def s5_mixer(u, lam_re, lam_im, log_dt, b_re, b_im, c_re, c_im, d, glu_w, glu_b):
    bsz, L, _ = u.shape
    uf = u.astype(F32).reshape(bsz, L, SSM_G, SSM_H)
    lam = lax.complex(lam_re.astype(F32), lam_im.astype(F32))
    dt = jnp.exp(log_dt.astype(F32))[:, None]
    a_bar = jnp.exp(lam * dt)
    b = lax.complex(b_re.astype(F32), b_im.astype(F32))
    b_bar = ((a_bar - 1.0) / lam)[..., None] * b
    bu = lax.complex(jnp.einsum('blgh,gph->blgp', uf, jnp.real(b_bar)),
                     jnp.einsum('blgh,gph->blgp', uf, jnp.imag(b_bar)))
    a_seq = jnp.broadcast_to(a_bar[None, None], (1, L, SSM_G, SSM_P))

    def combine(e1, e2):
        a1, s1 = e1
        a2, s2 = e2
        return a2 * a1, a2 * s1 + s2

    _, states = lax.associative_scan(combine, (a_seq, bu), axis=1)
    y = (jnp.einsum('blgp,ghp->blgh', jnp.real(states), c_re.astype(F32))
         - jnp.einsum('blgp,ghp->blgh', jnp.imag(states), c_im.astype(F32))
         + d.astype(F32) * uf)
    y = jax.nn.gelu(y.reshape(bsz, L, SSM_W))
    z = y @ glu_w.astype(F32) + glu_b.astype(F32)
    val, gate = jnp.split(z, 2, axis=-1)
    return (val * jax.nn.sigmoid(gate)).astype(u.dtype)


def mlstm_mixer(q, k, v, o_pre, i_pre, f_pre, conv_w, norm_g):
    bsz, L, _ = q.shape
    qk = jax.nn.silu(causal_dwconv(jnp.concatenate([q, k], axis=-1).astype(F32), conv_w))
    q, k = jnp.split(qk, 2, axis=-1)
    lp = L + PAD
    nc = lp // BLOCK
    valid_c = (jnp.arange(lp) >= PAD).reshape(nc, BLOCK)

    def heads(a):
        a = pad_front(a.astype(F32)).reshape(bsz, nc, BLOCK, ML_HEADS, ML_DH)
        return a.transpose(0, 3, 1, 2, 4)

    def gates(a):
        return pad_front(a).reshape(bsz, nc, BLOCK, ML_HEADS).transpose(0, 3, 1, 2)

    qh, kh, vh = heads(q), heads(k) * ML_DH ** -0.5, heads(v)
    log_i = jnp.where(valid_c, gates(i_pre), NEG)
    log_f = jnp.where(valid_c, gates(jax.nn.log_sigmoid(f_pre)), 0.0)

    b = jnp.cumsum(log_f, axis=-1)
    g = b[..., -1]
    a_state = g[..., None] - b + log_i
    m_loc = jnp.max(a_state, axis=-1)
    w_state = jnp.exp(a_state - m_loc[..., None])
    c_loc = jnp.einsum('bhcsv,bhcsk->bhcvk', vh * w_state[..., None], kh)
    n_loc = jnp.einsum('bhcs,bhcsk->bhck', w_state, kh)

    def step(carry, xs):
        c_prev, n_prev, m_prev = carry
        g_c, m_loc_c, c_loc_c, n_loc_c = xs
        m_new = jnp.maximum(g_c + m_prev, m_loc_c)
        decay = jnp.exp(g_c + m_prev - m_new)
        scale = jnp.exp(m_loc_c - m_new)
        c_new = decay[..., None, None] * c_prev + scale[..., None, None] * c_loc_c
        n_new = decay[..., None] * n_prev + scale[..., None] * n_loc_c
        return (c_new, n_new, m_new), (c_prev, n_prev, m_prev)

    init = (jnp.zeros((bsz, ML_HEADS, ML_DH, ML_DH), F32), jnp.zeros((bsz, ML_HEADS, ML_DH), F32),
            jnp.zeros((bsz, ML_HEADS), F32))
    xs = (jnp.moveaxis(g, 2, 0), jnp.moveaxis(m_loc, 2, 0), jnp.moveaxis(c_loc, 2, 0), jnp.moveaxis(n_loc, 2, 0))
    _, (c_st, n_st, m_st) = lax.scan(step, init, xs)
    c_st, n_st, m_st = jnp.moveaxis(c_st, 0, 2), jnp.moveaxis(n_st, 0, 2), jnp.moveaxis(m_st, 0, 2)

    t_idx = jnp.arange(BLOCK)
    causal = t_idx[:, None] >= t_idx[None, :]
    d_log = jnp.where(causal, b[..., :, None] - b[..., None, :] + log_i[..., None, :], NEG)
    m_inter = b + m_st[..., None]
    m_comb = jnp.maximum(m_inter, jnp.max(d_log, axis=-1))
    scores = jnp.einsum('bhctd,bhcsd->bhcts', qh, kh) * jnp.exp(d_log - m_comb[..., None])
    inter_w = jnp.exp(m_inter - m_comb)
    num = (jnp.einsum('bhcts,bhcsv->bhctv', scores, vh)
           + inter_w[..., None] * jnp.einsum('bhctk,bhcvk->bhctv', qh, c_st))
    den = jnp.sum(scores, axis=-1) + inter_w * jnp.einsum('bhctk,bhck->bhct', qh, n_st)
    h = num / jnp.maximum(jnp.abs(den), jnp.exp(-m_comb))[..., None]
    h = h.transpose(0, 2, 3, 1, 4).reshape(bsz, lp, ML_HEADS, ML_DH)[:, PAD:]
    h = h * lax.rsqrt(jnp.mean(h * h, axis=-1, keepdims=True) + EPS) * norm_g.astype(F32).reshape(ML_HEADS, ML_DH)
    h = h.reshape(bsz, L, GROUP_W) * jax.nn.sigmoid(o_pre.astype(F32))
    return h.astype(o_pre.dtype)


def fox_mixer(q, k, v, f_pre):
    bsz, L, _ = q.shape
    lp = L + PAD
    nb = lp // BLOCK

    def heads(a):
        return pad_front(a.astype(F32)).reshape(bsz, lp, FX_HEADS, FX_DH).transpose(0, 2, 1, 3)

    qh, kh, vh = heads(q) * FX_DH ** -0.5, heads(k), heads(v)
    pos = jnp.arange(lp)
    log_f = jnp.where(pos >= PAD, pad_front(jax.nn.log_sigmoid(f_pre)).transpose(0, 2, 1), 0.0)
    cum = jnp.cumsum(log_f, axis=-1)
    q_blocks = qh.reshape(bsz, FX_HEADS, nb, BLOCK, FX_DH).transpose(2, 0, 1, 3, 4)
    cum_blocks = cum.reshape(bsz, FX_HEADS, nb, BLOCK).transpose(2, 0, 1, 3)
    starts = jnp.arange(nb) * BLOCK

    def attend(args):
        q_b, cum_b, start = args
        q_pos = start + jnp.arange(BLOCK)
        mask = (pos[None, :] <= q_pos[:, None]) & (pos[None, :] >= PAD)
        logits = jnp.einsum('bhtd,bhsd->bhts', q_b, kh) + cum_b[..., None] - cum[..., None, :]
        p = jax.nn.softmax(jnp.where(mask, logits, NEG), axis=-1)
        return jnp.einsum('bhts,bhsd->bhtd', p, vh)

    out = lax.map(attend, (q_blocks, cum_blocks, starts))
    out = out.transpose(1, 0, 3, 2, 4).reshape(bsz, lp, GROUP_W)[:, PAD:]
    return out.astype(q.dtype)


def pool_mixer(u, pool_w, pool_scale):
    bsz, L, _ = u.shape
    uf = u.astype(F32)
    t = jnp.arange(1, L + 1).astype(F32)
    outs = []
    for grp, w in zip(jnp.split(uf, len(POOL_WINDOWS), axis=-1), POOL_WINDOWS):
        cs = jnp.pad(jnp.cumsum(grp, axis=1), ((0, 0), (w, 0), (0, 0)))
        win_mean = (cs[:, w:] - cs[:, :L]) / jnp.minimum(t, float(w))[None, :, None]
        outs.append(win_mean - grp)
    pooled = jnp.stack(outs, axis=2)
    mixed = jnp.einsum('blgc,gcd->blgd', pooled, pool_w.astype(F32)).reshape(bsz, L, GROUP_W)
    return (mixed * pool_scale.astype(F32)).astype(u.dtype)


def setup_inputs(seed: int = 0) -> dict:
    key = jax.random.key(seed)
    ks = iter(jax.random.split(key, 32))

    def nrm(shape, scale):
        return scale * jax.random.normal(next(ks), shape, F32)

    def gain(shape):
        return 1.0 + nrm(shape, 0.02)

    gate_lin = jnp.linspace(3.0, 6.0, ML_HEADS, dtype=F32)[None]
    log_dt = jax.random.uniform(next(ks), (DEPTH, SSM_G), F32, math.log(1e-3), math.log(1e-1))
    return {
        "x": nrm((BATCH, SEQ, D_MODEL), 1.0),
        "meta_tokens": nrm((N_META, D_MODEL), 1.0),
        "g_pre_mix": gain((DEPTH, D_MODEL)),
        "g_post_mix": gain((DEPTH, D_MODEL)),
        "g_pre_ffn": gain((DEPTH, D_MODEL)),
        "g_post_ffn": gain((DEPTH, D_MODEL)),
        "w_in": nrm((DEPTH, D_MODEL, IN_COLS), D_MODEL ** -0.5),
        "ml_gate_bias": jnp.concatenate([nrm((DEPTH, ML_HEADS), 0.1), gate_lin + nrm((DEPTH, ML_HEADS), 0.1)], axis=-1),
        "fx_gate_bias": jnp.linspace(3.0, 6.0, FX_HEADS, dtype=F32)[None] + nrm((DEPTH, FX_HEADS), 0.1),
        "ssm_lam_re": -0.5 + nrm((DEPTH, SSM_G, SSM_P), 0.01),
        "ssm_lam_im": math.pi * jnp.arange(SSM_P, dtype=F32)[None, None] + nrm((DEPTH, SSM_G, SSM_P), 0.01),
        "ssm_log_dt": log_dt,
        "ssm_b_re": nrm((DEPTH, SSM_G, SSM_P, SSM_H), (2 * SSM_H) ** -0.5),
        "ssm_b_im": nrm((DEPTH, SSM_G, SSM_P, SSM_H), (2 * SSM_H) ** -0.5),
        "ssm_c_re": nrm((DEPTH, SSM_G, SSM_H, SSM_P), (2 * SSM_P) ** -0.5),
        "ssm_c_im": nrm((DEPTH, SSM_G, SSM_H, SSM_P), (2 * SSM_P) ** -0.5),
        "ssm_d": nrm((DEPTH, SSM_G, SSM_H), 1.0),
        "ssm_glu_w": nrm((DEPTH, SSM_W, 2 * SSM_W), SSM_W ** -0.5),
        "ssm_glu_b": nrm((DEPTH, 2 * SSM_W), 0.01),
        "ml_conv_w": nrm((DEPTH, ML_CONV, 2 * GROUP_W), ML_CONV ** -0.5),
        "ml_norm_g": gain((DEPTH, GROUP_W)),
        "pool_w": nrm((DEPTH, len(POOL_WINDOWS), POOL_GW, POOL_GW), POOL_GW ** -0.5),
        "pool_scale": gain((DEPTH, GROUP_W)),
        "w_out": nrm((DEPTH, MIX_W, D_MODEL), MIX_W ** -0.5),
        "mlp_w1": nrm((DEPTH, D_MODEL, D_FF), D_MODEL ** -0.5),
        "mlp_w2": nrm((DEPTH, D_FF, D_MODEL), D_FF ** -0.5),
    }


def reference(x, meta_tokens, g_pre_mix, g_post_mix, g_pre_ffn, g_post_ffn, w_in, ml_gate_bias, fx_gate_bias,
              ssm_lam_re, ssm_lam_im, ssm_log_dt, ssm_b_re, ssm_b_im, ssm_c_re, ssm_c_im, ssm_d, ssm_glu_w,
              ssm_glu_b, ml_conv_w, ml_norm_g, pool_w, pool_scale, w_out, mlp_w1, mlp_w2):
    bsz = x.shape[0]
    meta = jnp.broadcast_to(meta_tokens[None], (bsz, N_META, D_MODEL)).astype(x.dtype)
    h = jnp.concatenate([meta, x], axis=1)
    split_idx = np.cumsum(IN_SPLIT)[:-1].tolist()
    for l in range(DEPTH):
        xn = rmsnorm(h, g_pre_mix[l])
        proj = xn @ w_in[l]
        (s_u, m_q, m_k, m_v, m_o, m_i, m_f, f_q, f_k, f_v, f_f, p_u) = jnp.split(proj, split_idx, axis=-1)
        gb = ml_gate_bias[l].astype(F32)
        y_ssm = s5_mixer(s_u, ssm_lam_re[l], ssm_lam_im[l], ssm_log_dt[l], ssm_b_re[l], ssm_b_im[l],
                         ssm_c_re[l], ssm_c_im[l], ssm_d[l], ssm_glu_w[l], ssm_glu_b[l])
        y_ml = mlstm_mixer(m_q, m_k, m_v, m_o, m_i.astype(F32) + gb[:ML_HEADS], m_f.astype(F32) + gb[ML_HEADS:],
                           ml_conv_w[l], ml_norm_g[l])
        y_fx = fox_mixer(f_q, f_k, f_v, f_f.astype(F32) + fx_gate_bias[l].astype(F32))
        y_pool = pool_mixer(p_u, pool_w[l], pool_scale[l])
        mix = jnp.concatenate([y_ssm, y_ml, y_fx, y_pool], axis=-1) @ w_out[l]
        h = h + rmsnorm(mix, g_post_mix[l])
        hn = rmsnorm(h, g_pre_ffn[l])
        ff = jnp.square(jax.nn.relu(hn @ mlp_w1[l])) @ mlp_w2[l]
        h = h + rmsnorm(ff, g_post_ffn[l])
    return h[:, N_META:]
```

```cpp
#include <hip/hip_runtime.h>
#include <hip/hip_cooperative_groups.h>
#include <cstdio>
namespace cg = cooperative_groups;

__device__ __forceinline__ int lt_tid() { int t = threadIdx.x; asm volatile("" : "+v"(t)); return t; }
namespace pg8 {
#define PG8_LAS __attribute__((address_space(3)))
typedef unsigned short bf16_t;
typedef short bf16x8 __attribute__((ext_vector_type(8)));
typedef float f32x4 __attribute__((ext_vector_type(4)));
typedef unsigned u32x4 __attribute__((ext_vector_type(4)));
constexpr int BM = 256, BK = 64, HALF = 128, HTB = HALF * BK * 2  , STAGE_BYTES = 8 * HTB, NXCD = 8, WGM = 8;

__host__ __device__ __forceinline__ int lds_byte(int r, int c) { const int st = (r >> 4) * 2 + (c >> 5), rr = r & 15, cc = c & 31, ob = rr * 64 + cc * 2; return st * 1024 + (ob ^ (((ob >> 9) & 1) << 5)); }
__host__ __device__ __forceinline__ void stage_rc(int b, int& R, int& C) { const int st = b / 1024, sb = b % 1024, swz = sb ^ (((sb >> 9) & 1) << 5); R = (st >> 1) * 16 + swz / 64; C = (st & 1) * 32 + (swz % 64) / 2; }
__host__ __device__ __forceinline__ int perm32(int rho) { const int n = rho >> 4, i = rho & 15; return 8 * (i >> 2) + 4 * n + (i & 3); }

struct Unit { int pm, pn; };
struct Gemm { const bf16_t* A; const bf16_t* Bt; int M, N, K; };

struct StaticOrder {
    int nM, nN, nwg, G, c;
    __host__ __device__ void init(int M, int N, int G_, int c_) { nM = M / BM; nN = N / BM; nwg = nM * nN; G = G_; c = c_; }
    __host__ __device__ bool next(int i, Unit& u) const {
        const long L = (long)i * G + c; if (L >= nwg) return false;
        int wgid = (int)L; { const int q = nwg / NXCD, r = nwg % NXCD, xcd = wgid % NXCD, off = wgid / NXCD; wgid = (xcd < r ? xcd * (q + 1) : r * (q + 1) + (xcd - r) * q) + off; }
        const int nig = WGM * nN, gid = wgid / nig, fm = gid * WGM, gsz = (nM - fm) < WGM ? (nM - fm) : WGM;
        u.pm = fm + ((wgid % nig) % gsz); u.pn = (wgid % nig) / gsz; return true;
    }
    __device__ __forceinline__ void a_ready(const Unit&) const {}
    __device__ __forceinline__ void done(const Unit&) const {}
};
__device__ __forceinline__ unsigned cvt_pk_bf16(float lo, float hi) { unsigned r; asm volatile("v_cvt_pk_bf16_f32 %0, %1, %2" : "=v"(r) : "v"(lo), "v"(hi)); return r; }

template <class Epi, class Sched, bool STAMP = false>
__device__ __forceinline__ void gemm_phase(PG8_LAS unsigned char* lds, const Gemm g, const Sched& S, const Epi& E, unsigned long long* stamps) {
    const int tid = lt_tid(), wid = __builtin_amdgcn_readfirstlane(tid >> 6), lane = tid & 63, wr = wid >> 2, wc = wid & 3, fr = lane & 15, fq = lane >> 4;
    const int K = g.K, nt = K / BK;
    int ts_lo = 0, ts_hi = 0, nts = 0; const unsigned long long rt_entry = STAMP ? (unsigned long long)wall_clock64() : 0ull;
#define PG8_STAMP() do { if (STAMP && wid == 0 && nts < 64) { const unsigned long long _c = (unsigned long long)clock64(); \
        ts_lo = (lane == nts) ? (int)(unsigned)_c : ts_lo; ts_hi = (lane == nts) ? (int)(unsigned)(_c >> 32) : ts_hi; ++nts; } } while (0)
    PG8_STAMP();
    unsigned voffA[2], voffB[2];
#pragma unroll
    for (int i = 0; i < 2; ++i) { int R, C; stage_rc(tid * 16 + i * 8192, R, C); const int Rb = Epi::PERM ? ((R & ~31) + perm32(R & 31)) : R;
        voffA[i] = (unsigned)(R * K + C) * 2u; voffB[i] = (unsigned)(Rb * K + C) * 2u; }
    const size_t kstep = (size_t)(BK * 2);
    const size_t hstep = (size_t)HALF * K * 2;
    const size_t tstep = 2 * hstep;
    const unsigned ldsw = (unsigned)wid * 1024u;
    const int aoff = lds_byte(wr * 64 + fr, fq * 8), boff = lds_byte(wc * 32 + fr, fq * 8);
#define PG8_SA(b, h) (((b) * 2 + (h)) * HTB)
#define PG8_SB(b, h) ((4 + (b) * 2 + (h)) * HTB)
#define PG8_STAGE(bufoff, gbase, voff) do { _Pragma("unroll") for (int _i = 0; _i < 2; ++_i) \
        __builtin_amdgcn_global_load_lds((const unsigned*)((const char*)(gbase) + (voff)[_i]), (PG8_LAS unsigned*)(lds + (bufoff) + ldsw + _i * 8192), 16, 0, 0); } while (0)
#define PG8_LDA(dst, b, h) do { _Pragma("unroll") for (int m = 0; m < 4; ++m) _Pragma("unroll") for (int k = 0; k < 2; ++k) dst[m][k] = *(const PG8_LAS bf16x8*)(lds + PG8_SA(b, h) + aoff + m * 2048 + k * 1024); } while (0)
#define PG8_LDB(dst, b, h) do { _Pragma("unroll") for (int n = 0; n < 2; ++n) _Pragma("unroll") for (int k = 0; k < 2; ++k) dst[n][k] = *(const PG8_LAS bf16x8*)(lds + PG8_SB(b, h) + boff + n * 2048 + k * 1024); } while (0)
#define PG8_MMA(ai, bj, At, Bt) do { __builtin_amdgcn_s_setprio(1); _Pragma("unroll") for (int m = 0; m < 4; ++m) _Pragma("unroll") for (int n = 0; n < 2; ++n) _Pragma("unroll") for (int k = 0; k < 2; ++k) \
        acc[ai][bj][m][n] = __builtin_amdgcn_mfma_f32_16x16x32_bf16(Bt[n][k], At[m][k], acc[ai][bj][m][n], 0, 0, 0); __builtin_amdgcn_s_setprio(0); } while (0)
#define PG8_WAIT_V(n) asm volatile("s_waitcnt vmcnt(" #n ")" ::: "memory")
#define PG8_WAIT_L(n) asm volatile("s_waitcnt lgkmcnt(" #n ")" ::: "memory")
#define PG8_BAR __builtin_amdgcn_s_barrier()
#define PG8_SCHED __builtin_amdgcn_sched_barrier(0)
    Unit cur, nxt; int ui = 0;
    if (!S.next(0, cur)) return;
    f32x4 acc[2][2][4][2];
#pragma unroll
    for (int a = 0; a < 2; ++a)
#pragma unroll
        for (int b = 0; b < 2; ++b)
#pragma unroll
            for (int m = 0; m < 4; ++m)
#pragma unroll
                for (int n = 0; n < 2; ++n) acc[a][b][m][n] = (f32x4){0.f, 0.f, 0.f, 0.f};
    bf16x8 At[4][2], B0[2][2], B1[2][2];
    const char* cA = (const char*)g.A + (size_t)cur.pm * tstep; const char* cB = (const char*)g.Bt + (size_t)cur.pn * tstep;
    S.a_ready(cur);
    PG8_STAGE(PG8_SB(0, 0), cB, voffB); PG8_STAGE(PG8_SA(0, 0), cA, voffA); PG8_STAGE(PG8_SB(0, 1), cB + hstep, voffB); PG8_STAGE(PG8_SA(0, 1), cA + hstep, voffA);
    if (wr == 1) PG8_BAR;
    PG8_WAIT_V(4); PG8_BAR;
    PG8_STAGE(PG8_SB(1, 0), cB + kstep, voffB); PG8_STAGE(PG8_SA(1, 0), cA + kstep, voffA); PG8_STAGE(PG8_SB(1, 1), cB + hstep + kstep, voffB);
    PG8_WAIT_V(6); PG8_BAR;
    PG8_STAMP();
    for (;;) {
        const bool has_next = S.next(ui + 1, nxt);
        const char* nA = has_next ? (const char*)g.A + (size_t)nxt.pm * tstep : cA; const char* nB = has_next ? (const char*)g.Bt + (size_t)nxt.pn * tstep : cB;
        for (int t = 0; t < nt; t += 2) {
            const bool last = (t == nt - 2);
            const char* a1 = cA + (size_t)(t + 1) * kstep;
            const char* a2 = last ? nA : cA + (size_t)(t + 2) * kstep; const char* b2 = last ? nB : cB + (size_t)(t + 2) * kstep;
            const char* a3 = a2 + kstep; const char* b3 = b2 + kstep;
            if (last && has_next) S.a_ready(nxt);
            PG8_LDB(B0, 0, 0); PG8_SCHED; PG8_LDA(At, 0, 0); PG8_STAGE(PG8_SA(1, 1), a1 + hstep, voffA);
            PG8_WAIT_L(8); PG8_BAR; PG8_WAIT_L(0); PG8_MMA(0, 0, At, B0); PG8_BAR; PG8_SCHED;
            PG8_LDB(B1, 0, 1); PG8_STAGE(PG8_SB(0, 0), b2, voffB);
            PG8_BAR; PG8_WAIT_L(0); PG8_MMA(0, 1, At, B1); PG8_BAR;
            PG8_LDA(At, 0, 1); PG8_STAGE(PG8_SA(0, 0), a2, voffA);
            PG8_BAR; PG8_WAIT_L(0); PG8_MMA(1, 0, At, B0); PG8_BAR; PG8_SCHED;
            PG8_STAGE(PG8_SB(0, 1), b2 + hstep, voffB);
            PG8_WAIT_V(6); PG8_BAR; PG8_MMA(1, 1, At, B1); PG8_BAR;
            PG8_LDB(B0, 1, 0); PG8_SCHED; PG8_LDA(At, 1, 0); PG8_STAGE(PG8_SA(0, 1), a2 + hstep, voffA);
            PG8_WAIT_L(8); PG8_BAR; PG8_WAIT_L(0); PG8_MMA(0, 0, At, B0); PG8_BAR; PG8_SCHED;
            PG8_LDB(B1, 1, 1); PG8_STAGE(PG8_SB(1, 0), b3, voffB);
            PG8_BAR; PG8_WAIT_L(0); PG8_MMA(0, 1, At, B1); PG8_BAR;
            PG8_LDA(At, 1, 1); PG8_STAGE(PG8_SA(1, 0), a3, voffA);
            PG8_BAR; PG8_WAIT_L(0); PG8_MMA(1, 0, At, B0); PG8_BAR; PG8_SCHED;
            PG8_STAGE(PG8_SB(1, 1), b3 + hstep, voffB);
            PG8_WAIT_V(6); PG8_BAR; PG8_MMA(1, 1, At, B1); PG8_BAR;
        }
        PG8_STAMP();
        if constexpr (!Epi::AFTER_DRAIN) { E(acc, cur, wr, wc, fr, fq); S.done(cur); }
        PG8_STAMP();
        if (!has_next) break;
#pragma unroll
        for (int a = 0; a < 2; ++a)
#pragma unroll
            for (int b = 0; b < 2; ++b)
#pragma unroll
                for (int m = 0; m < 4; ++m)
#pragma unroll
                    for (int n = 0; n < 2; ++n) acc[a][b][m][n] = (f32x4){0.f, 0.f, 0.f, 0.f};
        cur = nxt; cA = nA; cB = nB; ++ui;
    }
    PG8_WAIT_V(0);
    if (wr == 0) PG8_BAR;
    PG8_BAR;
    if constexpr (Epi::AFTER_DRAIN) { E.fused(acc, cur, wr, wc, fr, fq, lds, wid, lane); S.done(cur); }
    PG8_STAMP();
    if (STAMP && wid == 0) { stamps[lane] = lane < nts ? (((unsigned long long)(unsigned)ts_hi << 32) | (unsigned)ts_lo) : 0ull;
        if (lane == 62) stamps[62] = rt_entry; if (lane == 63) stamps[63] = (unsigned long long)wall_clock64(); }
#undef PG8_STAMP
#undef PG8_SA
#undef PG8_SB
#undef PG8_STAGE
#undef PG8_LDA
#undef PG8_LDB
#undef PG8_MMA
#undef PG8_WAIT_V
#undef PG8_WAIT_L
#undef PG8_BAR
#undef PG8_SCHED
}
}

using pg8::bf16_t; using pg8::bf16x8; using pg8::f32x4; using pg8::u32x4;
typedef short s16x4 __attribute__((ext_vector_type(4)));
#define LAS3 __attribute__((address_space(3)))

constexpr int NB = 4, LT = 4112, DM = 2048, MR = NB * LT  , MP = 16640, NCH = 33, LPF = 4224;
constexpr int NPROJ = 4608, NIN = 4864, DFF = 8192, DEPTH = 2;
constexpr int C_S5U = 0, C_MLQ = 512, C_MLK = 1024, C_MLV = 1536, C_MLO = 2048, C_FXQ = 2560, C_FXK = 3072, C_FXV = 3584, C_PLU = 4096;
constexpr float EPS = 1e-6f, NEGB = -1e30f, LOG2E = 1.4426950408889634f;

enum { I_X = 0, I_META, I_GPREMIX, I_GPOSTMIX, I_GPREFFN, I_GPOSTFFN, I_WIN, I_MLGB, I_FXGB, I_LRE, I_LIM, I_LOGDT, I_BRE, I_BIM,
       I_CRE, I_CIM, I_SD, I_GLUW, I_GLUB, I_CONVW, I_NORMG, I_POOLW, I_POOLS, I_WOUT, I_W1, I_W2, N_IN };
struct P { const float* in[N_IN]; float* out; unsigned char* ws; };

constexpr size_t AL(size_t x) { return (x + 255) & ~(size_t)255; }
constexpr size_t OFF_WIN = 0;
constexpr size_t OFF_WOUT = OFF_WIN + AL((size_t)NIN * DM * 2);
constexpr size_t OFF_W1 = OFF_WOUT + AL((size_t)DM * DM * 2);
constexpr size_t OFF_W2 = OFF_W1 + AL((size_t)DFF * DM * 2);
constexpr size_t OFF_WGLU = OFF_W2 + AL((size_t)DM * DFF * 2);
constexpr size_t OFF_WPOOL = OFF_WGLU + AL((size_t)1024 * 512 * 2);
constexpr size_t OFF_ABUF = OFF_WPOOL + AL((size_t)512 * 512 * 2);
constexpr size_t OFF_FBUF = OFF_ABUF + AL((size_t)MP * DM * 2);
constexpr size_t OFF_PROJ = OFF_FBUF;
constexpr size_t OFF_QC = OFF_PROJ + AL((size_t)MP * NPROJ * 2);
constexpr size_t OFF_KC = OFF_QC + AL((size_t)MR * 512 * 2);
constexpr size_t OFF_CLOC = OFF_KC + AL((size_t)MR * 512 * 2);
constexpr size_t OFF_SY = OFF_CLOC + AL((size_t)528 * 16384 * 4);
constexpr size_t OFF_POOLED = OFF_SY + AL((size_t)MP * 512 * 2);
constexpr size_t OFF_FEND = OFF_POOLED + AL((size_t)MP * 512 * 2);
constexpr size_t OFF_SMALL = OFF_FBUF + AL((size_t)MP * DFF * 2);
static_assert(OFF_FEND <= OFF_SMALL, "mixer scratch must fit inside FBUF");
constexpr size_t OFF_GATES = OFF_SMALL;
constexpr size_t OFF_CUM = OFF_GATES + AL((size_t)MP * 16 * 4);
constexpr size_t OFF_BCUM = OFF_CUM + AL((size_t)16 * LPF * 4);
constexpr size_t OFF_MLI = OFF_BCUM + AL((size_t)16 * LPF * 4);
constexpr size_t OFF_MLG = OFF_MLI + AL((size_t)16 * LPF * 4);
constexpr size_t OFF_MLM = OFF_MLG + AL(528 * 4);
constexpr size_t OFF_MST = OFF_MLM + AL(528 * 4);
constexpr size_t OFF_NLOC = OFF_MST + AL(528 * 4);
constexpr size_t OFF_S5E = OFF_NLOC + AL((size_t)528 * 128 * 4);
constexpr size_t OFF_S5IN = OFF_S5E + AL((size_t)NB * NCH * 2048 * 8);
constexpr size_t OFF_HMETA = OFF_S5IN + AL((size_t)NB * NCH * 2048 * 8);
constexpr size_t OFF_CTR = OFF_HMETA + AL((size_t)64 * DM * 4);
constexpr size_t OFF_END = OFF_CTR + 256;
static_assert(OFF_END <= (size_t)512 * 1024 * 1024, "workspace budget");

__device__ __forceinline__ float bf2f(unsigned short h) { return __uint_as_float(((unsigned)h) << 16); }
__device__ __forceinline__ unsigned pk2(float lo, float hi) { return pg8::cvt_pk_bf16(lo, hi); }
__device__ __forceinline__ float logsig(float x) { return fminf(x, 0.f) - log1pf(expf(-fabsf(x))); }
__device__ __forceinline__ float sigm(float x) { return 1.f / (1.f + __expf(-x)); }
__device__ __forceinline__ float wsum(float v) { for (int o = 32; o > 0; o >>= 1) v += __shfl_xor(v, o); return v; }
__device__ __forceinline__ float wmaxf(float v) { for (int o = 32; o > 0; o >>= 1) v = fmaxf(v, __shfl_xor(v, o)); return v; }
__device__ __forceinline__ float* hrow(const P& p, int r) {
    const int b = r / LT, t = r - b * LT;
    return t < 16 ? (float*)(p.ws + OFF_HMETA) + (size_t)(b * 16 + t) * DM : p.out + ((size_t)b * 4096 + (t - 16)) * DM;
}
__device__ __forceinline__ s16x4 trrd(const bf16_t* a) { return __builtin_amdgcn_ds_read_tr16_b64_v4i16((LAS3 s16x4*)a); }
__device__ __forceinline__ bf16x8 cat8(s16x4 a, s16x4 b) { return (bf16x8){a[0], a[1], a[2], a[3], b[0], b[1], b[2], b[3]}; }
#define MFMA16(A, B, C) __builtin_amdgcn_mfma_f32_16x16x32_bf16(A, B, C, 0, 0, 0)

struct EpiG1 {
    static constexpr bool PERM = true, AFTER_DRAIN = false;
    bf16_t* O; float* gates;
    __device__ __forceinline__ void operator()(const f32x4 (&acc)[2][2][4][2], const pg8::Unit& u, int wr, int wc, int fr_, int fq_) const {
        int fr = fr_, fq = fq_; asm volatile("" : "+v"(fr), "+v"(fq));
        const int row0 = u.pm * 256 + wr * 64 + fr;
        if (u.pn < 18) {
            const int col0 = u.pn * 256 + wc * 32 + 8 * fq;
#pragma unroll
            for (int ai = 0; ai < 2; ++ai)
#pragma unroll
                for (int m = 0; m < 4; ++m) { bf16_t* rowp = O + (size_t)(row0 + ai * 128 + m * 16) * NPROJ + col0;
#pragma unroll
                    for (int bj = 0; bj < 2; ++bj) { const f32x4 v0 = acc[ai][bj][m][0], v1 = acc[ai][bj][m][1];
                        u32x4 w; w.x = pk2(v0[0], v0[1]); w.y = pk2(v0[2], v0[3]); w.z = pk2(v1[0], v1[1]); w.w = pk2(v1[2], v1[3]);
                        *(u32x4*)(rowp + bj * 128) = w; } }
        } else if (wc == 0 && fq < 2) {
#pragma unroll
            for (int ai = 0; ai < 2; ++ai)
#pragma unroll
                for (int m = 0; m < 4; ++m) { float* gp = gates + (size_t)(row0 + ai * 128 + m * 16) * 16 + 8 * fq;
                    *(f32x4*)gp = acc[ai][0][m][0]; *(f32x4*)(gp + 4) = acc[ai][0][m][1]; }
        }
    }
};
template <int ACT> struct EpiB {
    static constexpr bool PERM = true, AFTER_DRAIN = false;
    bf16_t* O; int ldc;
    __device__ __forceinline__ void operator()(const f32x4 (&acc)[2][2][4][2], const pg8::Unit& u, int wr, int wc, int fr_, int fq_) const {
        int fr = fr_, fq = fq_; asm volatile("" : "+v"(fr), "+v"(fq));
        const int row0 = u.pm * 256 + wr * 64 + fr, col0 = u.pn * 256 + wc * 32 + 8 * fq;
#pragma unroll
        for (int ai = 0; ai < 2; ++ai)
#pragma unroll
            for (int m = 0; m < 4; ++m) { bf16_t* rowp = O + (size_t)(row0 + ai * 128 + m * 16) * ldc + col0;
#pragma unroll
                for (int bj = 0; bj < 2; ++bj) { f32x4 v0 = acc[ai][bj][m][0], v1 = acc[ai][bj][m][1];
                    if (ACT == 1) {
#pragma unroll
                        for (int j = 0; j < 4; ++j) { const float a = fmaxf(v0[j], 0.f), b = fmaxf(v1[j], 0.f); v0[j] = a * a; v1[j] = b * b; } }
                    u32x4 w; w.x = pk2(v0[0], v0[1]); w.y = pk2(v0[2], v0[3]); w.z = pk2(v1[0], v1[1]); w.w = pk2(v1[2], v1[3]);
                    *(u32x4*)(rowp + bj * 128) = w; } }
    }
};
struct EpiGLU {
    static constexpr bool PERM = true, AFTER_DRAIN = false;
    bf16_t* O; const float* bias;
    __device__ __forceinline__ void operator()(const f32x4 (&acc)[2][2][4][2], const pg8::Unit& u, int wr, int wc, int fr_, int fq_) const {
        int fr = fr_, fq = fq_; asm volatile("" : "+v"(fr), "+v"(fq));
        const int row0 = u.pm * 256 + wr * 64 + fr, oc = u.pn * 128 + wc * 32 + 8 * fq;
        const f32x4 bv0 = *(const f32x4*)(bias + oc), bv1 = *(const f32x4*)(bias + oc + 4), bg0 = *(const f32x4*)(bias + 512 + oc), bg1 = *(const f32x4*)(bias + 512 + oc + 4);
#pragma unroll
        for (int ai = 0; ai < 2; ++ai)
#pragma unroll
            for (int m = 0; m < 4; ++m) {
                f32x4 v0 = acc[ai][0][m][0] + bv0, v1 = acc[ai][0][m][1] + bv1; const f32x4 g0 = acc[ai][1][m][0] + bg0, g1 = acc[ai][1][m][1] + bg1;
#pragma unroll
                for (int j = 0; j < 4; ++j) { v0[j] *= sigm(g0[j]); v1[j] *= sigm(g1[j]); }
                u32x4 w; w.x = pk2(v0[0], v0[1]); w.y = pk2(v0[2], v0[3]); w.z = pk2(v1[0], v1[1]); w.w = pk2(v1[2], v1[3]);
                *(u32x4*)(O + (size_t)(row0 + ai * 128 + m * 16) * DM + oc) = w; }
    }
};
struct EpiPool {
    static constexpr bool PERM = true, AFTER_DRAIN = false;
    bf16_t* O; const float* scale;
    __device__ __forceinline__ void operator()(const f32x4 (&acc)[2][2][4][2], const pg8::Unit& u, int wr, int wc, int fr_, int fq_) const {
        int fr = fr_, fq = fq_; asm volatile("" : "+v"(fr), "+v"(fq));
        const int row0 = u.pm * 256 + wr * 64 + fr, col0 = u.pn * 256 + wc * 32 + 8 * fq;
#pragma unroll
        for (int bj = 0; bj < 2; ++bj) { const f32x4 s0 = *(const f32x4*)(scale + col0 + bj * 128), s1 = *(const f32x4*)(scale + col0 + bj * 128 + 4);
#pragma unroll
            for (int ai = 0; ai < 2; ++ai)
#pragma unroll
                for (int m = 0; m < 4; ++m) { const f32x4 v0 = acc[ai][bj][m][0] * s0, v1 = acc[ai][bj][m][1] * s1;
                    u32x4 w; w.x = pk2(v0[0], v0[1]); w.y = pk2(v0[2], v0[3]); w.z = pk2(v1[0], v1[1]); w.w = pk2(v1[2], v1[3]);
                    *(u32x4*)(O + (size_t)(row0 + ai * 128 + m * 16) * DM + 1536 + col0 + bj * 128) = w; } }
    }
};
struct EpiF32 {
    static constexpr bool PERM = false, AFTER_DRAIN = false;
    float* C; int ldc;
    __device__ __forceinline__ void operator()(const f32x4 (&acc)[2][2][4][2], const pg8::Unit& u, int wr, int wc, int fr_, int fq_) const {
        int fr = fr_, fq = fq_; asm volatile("" : "+v"(fr), "+v"(fq));
        const int row0 = u.pm * 256 + wr * 64 + fr, col0 = u.pn * 256 + wc * 32 + 4 * fq;
#pragma unroll
        for (int ai = 0; ai < 2; ++ai)
#pragma unroll
            for (int m = 0; m < 4; ++m) { float* rowp = C + (size_t)(row0 + ai * 128 + m * 16) * ldc + col0;
#pragma unroll
                for (int bj = 0; bj < 2; ++bj)
#pragma unroll
                    for (int n = 0; n < 2; ++n) *(f32x4*)(rowp + bj * 128 + n * 16) = acc[ai][bj][m][n]; }
    }
};
template <class Epi> __device__ __forceinline__ void run_gemm(unsigned char* smem, const bf16_t* A, const bf16_t* Bt, int N, int K, const Epi& E, int cshift) {
    pg8::Gemm g; g.A = A; g.Bt = Bt; g.M = MP; g.N = N; g.K = K;
    pg8::StaticOrder S; S.init(MP, N, gridDim.x, (blockIdx.x + cshift) % gridDim.x);
    pg8::gemm_phase<Epi, pg8::StaticOrder, false>((PG8_LAS unsigned char*)smem, g, S, E, nullptr);
}

__device__ __forceinline__ float wload(int mode, const float* src, int k, int n) {
    if (mode == 0) {
        int c;
        if (n < NPROJ) c = n + (n >= 2560 ? 8 : 0) + (n >= 4096 ? 4 : 0);
        else if (n < NPROJ + 8) c = 2560 + (n - NPROJ);
        else if (n < NPROJ + 12) c = 4104 + (n - NPROJ - 8);
        else return 0.f;
        return src[(size_t)k * 4620 + c];
    } else if (mode == 1) { return src[(size_t)k * DM + n]; }
    else if (mode == 2) { return src[(size_t)k * DFF + n]; }
    else if (mode == 3) { const int pn = n >> 8, i = n & 255; const int c = i < 128 ? pn * 128 + i : 512 + pn * 128 + (i - 128); return src[(size_t)k * 1024 + c]; }
    else { const int g = n >> 7; return (k >> 7) == g ? src[((size_t)g * 128 + (k & 127)) * 128 + (n & 127)] : 0.f; }
}
__device__ void convert_phase(const P& p, int l, unsigned char* smem) {
    float* tile = (float*)smem;
    const int tid = lt_tid();
    const int nt0 = (NIN / 64) * 32, nt1 = 32 * 32, nt2 = 128 * 32, nt3 = 32 * 128, nt4 = 16 * 8, nt5 = 8 * 8;
    const int total = nt0 + nt1 + nt2 + nt3 + nt4 + nt5;
    for (int tI = blockIdx.x; tI < total; tI += gridDim.x) {
        int x = tI, mode, K; const float* src; bf16_t* dst;
        if (x < nt0) { mode = 0; K = 2048; src = p.in[I_WIN] + (size_t)l * DM * 4620; dst = (bf16_t*)(p.ws + OFF_WIN); }
        else if ((x -= nt0) < nt1) { mode = 1; K = 2048; src = p.in[I_WOUT] + (size_t)l * DM * DM; dst = (bf16_t*)(p.ws + OFF_WOUT); }
        else if ((x -= nt1) < nt2) { mode = 2; K = 2048; src = p.in[I_W1] + (size_t)l * DM * DFF; dst = (bf16_t*)(p.ws + OFF_W1); }
        else if ((x -= nt2) < nt3) { mode = 1; K = 8192; src = p.in[I_W2] + (size_t)l * DFF * DM; dst = (bf16_t*)(p.ws + OFF_W2); }
        else if ((x -= nt3) < nt4) { mode = 3; K = 512; src = p.in[I_GLUW] + (size_t)l * 512 * 1024; dst = (bf16_t*)(p.ws + OFF_WGLU); }
        else { x -= nt4; mode = 4; K = 512; src = p.in[I_POOLW] + (size_t)l * 4 * 128 * 128; dst = (bf16_t*)(p.ws + OFF_WPOOL); }
        const int ktiles = K / 64, kt = x % ktiles, ntl = x / ktiles, k0 = kt * 64, n0 = ntl * 64;
#pragma unroll
        for (int i = 0; i < 8; ++i) { const int e = tid + 512 * i, kk = e >> 6, nn = e & 63; tile[kk * 65 + nn] = wload(mode, src, k0 + kk, n0 + nn); }
        __syncthreads();
        { const int kg = tid & 7, nn = tid >> 3; float v[8];
#pragma unroll
          for (int i = 0; i < 8; ++i) v[i] = tile[(kg * 8 + i) * 65 + nn];
          u32x4 w; w.x = pk2(v[0], v[1]); w.y = pk2(v[2], v[3]); w.z = pk2(v[4], v[5]); w.w = pk2(v[6], v[7]);
          *(u32x4*)(dst + (size_t)(n0 + nn) * K + k0 + kg * 8) = w; }
        __syncthreads();
    }
}

__device__ __forceinline__ void store_norm_bf16(bf16_t* dstrow, const f32x4 (&v)[8], float rstd, const float* g, int lane) {
#pragma unroll
    for (int i = 0; i < 8; ++i) { const int c = 256 * i + 4 * lane; const f32x4 gg = *(const f32x4*)(g + c);
        uint2 w; w.x = pk2(v[i][0] * rstd * gg[0], v[i][1] * rstd * gg[1]); w.y = pk2(v[i][2] * rstd * gg[2], v[i][3] * rstd * gg[3]);
        *(uint2*)(dstrow + c) = w; }
}
__device__ __forceinline__ float sumsq(const f32x4 (&v)[8]) {
    float s = 0.f;
#pragma unroll
    for (int i = 0; i < 8; ++i) s += v[i][0] * v[i][0] + v[i][1] * v[i][1] + v[i][2] * v[i][2] + v[i][3] * v[i][3];
    return wsum(s);
}
__device__ __forceinline__ const float* in_row(const P& p, int r) {
    const int b = r / LT, t = r - b * LT;
    return t < 16 ? p.in[I_META] + (size_t)t * DM : p.in[I_X] + ((size_t)b * 4096 + (t - 16)) * DM;
}
__device__ void row_first(const P& p) {
    const int lane = lt_tid() & 63, gw = blockIdx.x * 8 + (lt_tid() >> 6), nw = gridDim.x * 8;
    bf16_t* abuf = (bf16_t*)(p.ws + OFF_ABUF);
    for (int r = gw; r < MR; r += nw) {
        const float* src = in_row(p, r); f32x4 v[8];
#pragma unroll
        for (int i = 0; i < 8; ++i) v[i] = *(const f32x4*)(src + 256 * i + 4 * lane);
        const float rstd = rsqrtf(sumsq(v) * (1.f / DM) + EPS);
        store_norm_bf16(abuf + (size_t)r * DM, v, rstd, p.in[I_GPREMIX], lane);
    }
}
__device__ void row_postmix(const P& p, int l) {
    const int lane = lt_tid() & 63, gw = blockIdx.x * 8 + (lt_tid() >> 6), nw = gridDim.x * 8;
    bf16_t* abuf = (bf16_t*)(p.ws + OFF_ABUF); const float* mix = (const float*)(p.ws + OFF_FBUF);
    const float* gpm = p.in[I_GPOSTMIX] + l * DM; const float* gpf = p.in[I_GPREFFN] + l * DM;
    for (int r = gw; r < MR; r += nw) {
        const float* hs = l == 0 ? in_row(p, r) : hrow(p, r); float* hd = hrow(p, r);
        f32x4 v[8], h[8];
#pragma unroll
        for (int i = 0; i < 8; ++i) { v[i] = *(const f32x4*)(mix + (size_t)r * DM + 256 * i + 4 * lane); h[i] = *(const f32x4*)(hs + 256 * i + 4 * lane); }
        const float rm = rsqrtf(sumsq(v) * (1.f / DM) + EPS);
#pragma unroll
        for (int i = 0; i < 8; ++i) { const f32x4 gg = *(const f32x4*)(gpm + 256 * i + 4 * lane); h[i] = h[i] + v[i] * rm * gg; *(f32x4*)(hd + 256 * i + 4 * lane) = h[i]; }
        const float rh = rsqrtf(sumsq(h) * (1.f / DM) + EPS);
        store_norm_bf16(abuf + (size_t)r * DM, h, rh, gpf, lane);
    }
}
__device__ void row_postffn(const P& p, int l) {
    const int lane = lt_tid() & 63, gw = blockIdx.x * 8 + (lt_tid() >> 6), nw = gridDim.x * 8;
    bf16_t* abuf = (bf16_t*)(p.ws + OFF_ABUF);
    const float* gpf = p.in[I_GPOSTFFN] + l * DM; const bool last = (l == DEPTH - 1);
    for (int r = gw; r < MR; r += nw) {
        if (last && (r % LT) < 16) continue;
        float* hd = hrow(p, r); f32x4 v[8], h[8];
#pragma unroll
        for (int i = 0; i < 8; ++i) { const uint2 w = *(const uint2*)(abuf + (size_t)r * DM + 256 * i + 4 * lane);
            v[i] = (f32x4){__uint_as_float(w.x << 16), __uint_as_float(w.x & 0xffff0000u), __uint_as_float(w.y << 16), __uint_as_float(w.y & 0xffff0000u)};
            h[i] = *(const f32x4*)(hd + 256 * i + 4 * lane); }
        const float rm = rsqrtf(sumsq(v) * (1.f / DM) + EPS);
#pragma unroll
        for (int i = 0; i < 8; ++i) { const f32x4 gg = *(const f32x4*)(gpf + 256 * i + 4 * lane); h[i] = h[i] + v[i] * rm * gg; *(f32x4*)(hd + 256 * i + 4 * lane) = h[i]; }
        if (!last) { const float rh = rsqrtf(sumsq(h) * (1.f / DM) + EPS); store_norm_bf16(abuf + (size_t)r * DM, h, rh, p.in[I_GPREMIX] + (l + 1) * DM, lane); }
    }
}

struct S5Par { float ar, ai; float bbr[16], bbi[16]; };
__device__ __forceinline__ void s5_params(const P& p, int l, int g, int pp, S5Par& q) {
    const int gi = l * 32 + g; const float lre = p.in[I_LRE][gi * 64 + pp], lim = p.in[I_LIM][gi * 64 + pp], dt = expf(p.in[I_LOGDT][gi]);
    const float er = expf(lre * dt); float sn, cs; sincosf(lim * dt, &sn, &cs); q.ar = er * cs; q.ai = er * sn;
    const float nr = q.ar - 1.f, ni = q.ai, den = 1.f / (lre * lre + lim * lim);
    const float cr = (nr * lre + ni * lim) * den, ci = (ni * lre - nr * lim) * den;
    const float* br = p.in[I_BRE] + ((size_t)gi * 64 + pp) * 16; const float* bi = p.in[I_BIM] + ((size_t)gi * 64 + pp) * 16;
#pragma unroll
    for (int h = 0; h < 16; ++h) { const float x = br[h], y = bi[h]; q.bbr[h] = cr * x - ci * y; q.bbi[h] = cr * y + ci * x; }
}
__device__ __forceinline__ void s5_step(const S5Par& q, const bf16_t* uptr, float& sr, float& si) {
    const uint4 a = *(const uint4*)uptr, b = *(const uint4*)(uptr + 8);
    const unsigned w[8] = {a.x, a.y, a.z, a.w, b.x, b.y, b.z, b.w};
    float bur = 0.f, bui = 0.f;
#pragma unroll
    for (int i = 0; i < 8; ++i) { const float u0 = __uint_as_float(w[i] << 16), u1 = __uint_as_float(w[i] & 0xffff0000u);
        bur = fmaf(u0, q.bbr[2 * i], bur); bui = fmaf(u0, q.bbi[2 * i], bui); bur = fmaf(u1, q.bbr[2 * i + 1], bur); bui = fmaf(u1, q.bbi[2 * i + 1], bui); }
    const float nsr = q.ar * sr - q.ai * si + bur, nsi = q.ar * si + q.ai * sr + bui; sr = nsr; si = nsi;
}
__device__ void s5_pass1(const P& p, int l, int jb) {
    const int wid = __builtin_amdgcn_readfirstlane(lt_tid() >> 6), lane = lt_tid() & 63;
    const int b = jb / 132, rem = jb % 132, c = rem >> 2, g = (rem & 3) * 8 + wid;
    S5Par q; s5_params(p, l, g, lane, q);
    const int t0 = c == 0 ? 0 : 128 * c - 112, nt = c == 0 ? 16 : 128;
    const bf16_t* up = (const bf16_t*)(p.ws + OFF_PROJ) + (size_t)(b * LT + t0) * NPROJ + C_S5U + g * 16;
    float sr = 0.f, si = 0.f;
    for (int t = 0; t < nt; ++t) s5_step(q, up + (size_t)t * NPROJ, sr, si);
    ((float2*)(p.ws + OFF_S5E))[(size_t)(b * NCH + c) * 2048 + g * 64 + lane] = make_float2(sr, si);
}
__device__ void s5_carry(const P& p, int l, int jb) {
    const int id = jb * 512 + lt_tid(), b = id >> 11, gp = id & 2047, gi = l * 32 + (gp >> 6);
    const float lre = p.in[I_LRE][gi * 64 + (gp & 63)], lim = p.in[I_LIM][gi * 64 + (gp & 63)], dt = expf(p.in[I_LOGDT][gi]);
    const float er = expf(128.f * lre * dt); float sn, cs; sincosf(128.f * lim * dt, &sn, &cs); const float ar = er * cs, ai = er * sn;
    const float2* E = (const float2*)(p.ws + OFF_S5E); float2* SI = (float2*)(p.ws + OFF_S5IN);
    float sr = 0.f, si = 0.f;
    for (int c = 0; c < NCH; ++c) { const size_t ix = (size_t)(b * NCH + c) * 2048 + gp; SI[ix] = make_float2(sr, si); const float2 e = E[ix];
        const float nsr = ar * sr - ai * si + e.x, nsi = ar * si + ai * sr + e.y; sr = nsr; si = nsi; }
}
__device__ __forceinline__ float gelu_tanh(float y) { const float z = 0.7978845608028654f * (y + 0.044715f * y * y * y); const float th = 1.f - 2.f / (__expf(2.f * z) + 1.f); return 0.5f * y * (1.f + th); }
__device__ void s5_pass2(const P& p, int l, int jb, unsigned char* smem) {
    const int wid = __builtin_amdgcn_readfirstlane(lt_tid() >> 6), lane = lt_tid() & 63, ln = lane & 15, g4 = lane >> 4;
    const int b = jb / 132, rem = jb % 132, c = rem >> 2, g = (rem & 3) * 8 + wid, gi = l * 32 + g;
    bf16_t* Xs = (bf16_t*)smem + wid * (16 * 136);
    S5Par q; s5_params(p, l, g, lane, q);
    bf16x8 cf[4];
#pragma unroll
    for (int ks = 0; ks < 4; ++ks) { const int pp = 16 * ks + 4 * g4;
        const f32x4 cr = *(const f32x4*)(p.in[I_CRE] + ((size_t)gi * 16 + ln) * 64 + pp), ci = *(const f32x4*)(p.in[I_CIM] + ((size_t)gi * 16 + ln) * 64 + pp);
        u32x4 w; w.x = pk2(cr[0], -ci[0]); w.y = pk2(cr[1], -ci[1]); w.z = pk2(cr[2], -ci[2]); w.w = pk2(cr[3], -ci[3]); cf[ks] = *(bf16x8*)&w; }
    const float dv = p.in[I_SD][gi * 16 + ln];
    const int t0 = c == 0 ? 0 : 128 * c - 112, nt = c == 0 ? 16 : 128;
    const bf16_t* up = (const bf16_t*)(p.ws + OFF_PROJ) + (size_t)(b * LT + t0) * NPROJ + C_S5U + g * 16;
    bf16_t* sy = (bf16_t*)(p.ws + OFF_SY) + (size_t)(b * LT + t0) * 512 + g * 16;
    const float2 s0 = ((const float2*)(p.ws + OFF_S5IN))[(size_t)(b * NCH + c) * 2048 + g * 64 + lane];
    float sr = s0.x, si = s0.y;
    for (int tg = 0; tg < nt; tg += 16) {
#pragma unroll 4
        for (int tl = 0; tl < 16; ++tl) { s5_step(q, up + (size_t)(tg + tl) * NPROJ, sr, si); *(unsigned*)(Xs + tl * 136 + 2 * lane) = pk2(sr, si); }
        __builtin_amdgcn_wave_barrier();
        f32x4 acc = {0.f, 0.f, 0.f, 0.f};
#pragma unroll
        for (int ks = 0; ks < 4; ++ks) { const bf16x8 a = *(const bf16x8*)(Xs + ln * 136 + 32 * ks + 8 * g4); acc = MFMA16(a, cf[ks], acc); }
#pragma unroll
        for (int j = 0; j < 4; ++j) { const int tk = tg + 4 * g4 + j; const float u = bf2f(up[(size_t)tk * NPROJ + ln]);
            const float y = gelu_tanh(acc[j] + dv * u); sy[(size_t)tk * 512 + ln] = (bf16_t)(pk2(y, 0.f) & 0xffffu); }
        __builtin_amdgcn_wave_barrier();
    }
}

__device__ void pool_pre(const P& p, int jb) {
    const bf16_t* proj = (const bf16_t*)(p.ws + OFF_PROJ); bf16_t* pooled = (bf16_t*)(p.ws + OFF_POOLED);
    const int cg8 = lt_tid() & 63, c = cg8 * 8, w = 2 << (c >> 7);
    for (int it = 0; it < 4; ++it) {
        const int r = jb * 32 + it * 8 + (lt_tid() >> 6); if (r >= MR) break;
        const int t = r % LT, cnt = min(t + 1, w);
        float s[8] = {0, 0, 0, 0, 0, 0, 0, 0}, u0[8];
        for (int j = 0; j < cnt; ++j) { const uint4 x = *(const uint4*)(proj + (size_t)(r - j) * NPROJ + C_PLU + c); const unsigned xw[4] = {x.x, x.y, x.z, x.w};
#pragma unroll
            for (int i = 0; i < 4; ++i) { const float a = __uint_as_float(xw[i] << 16), bq = __uint_as_float(xw[i] & 0xffff0000u); s[2 * i] += a; s[2 * i + 1] += bq; if (j == 0) { u0[2 * i] = a; u0[2 * i + 1] = bq; } } }
        const float inv = 1.f / (float)cnt; u32x4 o;
        o.x = pk2(s[0] * inv - u0[0], s[1] * inv - u0[1]); o.y = pk2(s[2] * inv - u0[2], s[3] * inv - u0[3]); o.z = pk2(s[4] * inv - u0[4], s[5] * inv - u0[5]); o.w = pk2(s[6] * inv - u0[6], s[7] * inv - u0[7]);
        *(u32x4*)(pooled + (size_t)r * 512 + c) = o;
    }
}
__device__ void fox_cum(const P& p, int l, int bh) {
    if (lt_tid() >= 64) return;
    const int lane = lt_tid(), b = bh >> 2, h = bh & 3; const float bias = p.in[I_FXGB][l * 4 + h];
    const float* gates = (const float*)(p.ws + OFF_GATES); float* cum = (float*)(p.ws + OFF_CUM) + bh * LPF;
    for (int i = lane; i < 112; i += 64) cum[i] = 0.f;
    const int ta = lane * 65, tb = min(ta + 65, LT);
    float s = 0.f;
    for (int t = ta; t < tb; ++t) s += logsig(gates[(size_t)(b * LT + t) * 16 + 8 + h] + bias);
    float inc = s;
    for (int o = 1; o < 64; o <<= 1) { const float n = __shfl_up(inc, o); if (lane >= o) inc += n; }
    float run = inc - s;
    for (int t = ta; t < tb; ++t) { run += logsig(gates[(size_t)(b * LT + t) * 16 + 8 + h] + bias); cum[112 + t] = run; }
}

__device__ void ml_pass1(const P& p, int l, int j, unsigned char* smem) {
    const int tid = lt_tid(), wid = __builtin_amdgcn_readfirstlane(tid >> 6), lane = tid & 63, ln = lane & 15, g = lane >> 4, q4 = (lane >> 2) & 3, p4 = lane & 3;
    const int bh = j / NCH, c = j % NCH, b = bh >> 2, h = bh & 3, t0 = 128 * c - 112;
    bf16_t* Vs = (bf16_t*)smem;
    bf16_t* Kw = Vs + 128 * 144;
    float* fw = (float*)(Kw + 128 * 144);
    float* fx = fw + 128;
    const bf16_t* proj = (const bf16_t*)(p.ws + OFF_PROJ); const float* gates = (const float*)(p.ws + OFF_GATES);
    float lf = 0.f, li = NEGB, bs = 0.f;
    if (tid < 128) { const int t = t0 + tid;
        if (t >= 0) { const float* gp = gates + (size_t)(b * LT + t) * 16; li = gp[h] + p.in[I_MLGB][l * 8 + h]; lf = logsig(gp[4 + h] + p.in[I_MLGB][l * 8 + 4 + h]); }
        bs = lf;
        for (int o = 1; o < 64; o <<= 1) { const float n = __shfl_up(bs, o); if (lane >= o) bs += n; }
        if (tid == 63) fx[0] = bs; }
    __syncthreads();
    if (tid >= 64 && tid < 128) bs += fx[0];
    if (tid == 127) fx[1] = bs;
    __syncthreads();
    const float gtot = fx[1];
    float as = NEGB;
    if (tid < 128) { as = gtot - bs + li; const float mw = wmaxf(as); if (lane == 0) fx[2 + wid] = mw; }
    __syncthreads();
    const float mloc = fmaxf(fx[2], fx[3]);
    if (tid < 128) { fw[tid] = expf(as - mloc);
        ((float*)(p.ws + OFF_BCUM))[bh * LPF + 128 * c + tid] = bs; ((float*)(p.ws + OFF_MLI))[bh * LPF + 128 * c + tid] = li;
        if (tid == 0) { ((float*)(p.ws + OFF_MLG))[j] = gtot; ((float*)(p.ws + OFF_MLM))[j] = mloc; } }
    __syncthreads();
    const float* cw = p.in[I_CONVW] + (size_t)l * 4 * 1024;
    bf16_t* qc = (bf16_t*)(p.ws + OFF_QC); bf16_t* kc = (bf16_t*)(p.ws + OFF_KC);
#pragma unroll 1
    for (int it = 0; it < 8; ++it) {
        const int id = tid + 512 * (it & 3), s = id >> 4, dg = id & 15, isk = it >> 2, t = t0 + s;
        const int ch = h * 128 + dg * 8;
        float a[8] = {0, 0, 0, 0, 0, 0, 0, 0};
        if (t >= 0) {
            for (int jj = 0; jj < 4; ++jj) { const int tt = t - 3 + jj; if (tt < 0) continue;
                const uint4 x = *(const uint4*)(proj + (size_t)(b * LT + tt) * NPROJ + (isk ? C_MLK : C_MLQ) + ch); const unsigned xw[4] = {x.x, x.y, x.z, x.w};
                const float* wp = cw + jj * 1024 + isk * 512 + ch;
#pragma unroll
                for (int i = 0; i < 4; ++i) { a[2 * i] = fmaf(__uint_as_float(xw[i] << 16), wp[2 * i], a[2 * i]); a[2 * i + 1] = fmaf(__uint_as_float(xw[i] & 0xffff0000u), wp[2 * i + 1], a[2 * i + 1]); } }
#pragma unroll
            for (int i = 0; i < 8; ++i) a[i] = a[i] / (1.f + __expf(-a[i]));
        }
        if (!isk) { if (t >= 0) { u32x4 o; o.x = pk2(a[0], a[1]); o.y = pk2(a[2], a[3]); o.z = pk2(a[4], a[5]); o.w = pk2(a[6], a[7]); *(u32x4*)(qc + (size_t)(b * LT + t) * 512 + ch) = o; } }
        else {
#pragma unroll
            for (int i = 0; i < 8; ++i) a[i] *= 0.08838834764831845f;
            if (t >= 0) { u32x4 o; o.x = pk2(a[0], a[1]); o.y = pk2(a[2], a[3]); o.z = pk2(a[4], a[5]); o.w = pk2(a[6], a[7]); *(u32x4*)(kc + (size_t)(b * LT + t) * 512 + ch) = o; }
            const float ws = t >= 0 ? fw[s] : 0.f;
            u32x4 o; o.x = pk2(a[0] * ws, a[1] * ws); o.y = pk2(a[2] * ws, a[3] * ws); o.z = pk2(a[4] * ws, a[5] * ws); o.w = pk2(a[6] * ws, a[7] * ws);
            *(u32x4*)(Kw + s * 144 + dg * 8) = o;
            uint4 vv = make_uint4(0, 0, 0, 0); if (t >= 0) vv = *(const uint4*)(proj + (size_t)(b * LT + t) * NPROJ + C_MLV + ch);
            *(uint4*)(Vs + s * 144 + dg * 8) = vv;
        }
    }
    __syncthreads();
    f32x4 acc[8];
#pragma unroll
    for (int nt = 0; nt < 8; ++nt) acc[nt] = (f32x4){0.f, 0.f, 0.f, 0.f};
#pragma unroll
    for (int ks = 0; ks < 4; ++ks) {
        const int r0 = 32 * ks + 8 * g + q4;
        const bf16x8 af = cat8(trrd(Vs + r0 * 144 + 16 * wid + 4 * p4), trrd(Vs + (r0 + 4) * 144 + 16 * wid + 4 * p4));
#pragma unroll
        for (int nt = 0; nt < 8; ++nt) { const bf16x8 bfr = cat8(trrd(Kw + r0 * 144 + 16 * nt + 4 * p4), trrd(Kw + (r0 + 4) * 144 + 16 * nt + 4 * p4)); acc[nt] = MFMA16(af, bfr, acc[nt]); }
    }
    float* cl = (float*)(p.ws + OFF_CLOC) + (size_t)j * 16384;
#pragma unroll
    for (int nt = 0; nt < 8; ++nt)
#pragma unroll
        for (int jj = 0; jj < 4; ++jj) cl[(16 * wid + 4 * g + jj) * 128 + 16 * nt + ln] = acc[nt][jj];
    if (tid < 128) { float s = 0.f; for (int ss = 0; ss < 128; ++ss) s += bf2f(Kw[ss * 144 + tid]); ((float*)(p.ws + OFF_NLOC))[j * 128 + tid] = s; }
    __syncthreads();
}
__device__ void ml_scan(const P& p, int jb) {
    const int bh = jb >> 3, part = jb & 7, tid = lt_tid();
    float* cl = (float*)(p.ws + OFF_CLOC); float* nl = (float*)(p.ws + OFF_NLOC);
    const float* G = (const float*)(p.ws + OFF_MLG); const float* ML = (const float*)(p.ws + OFF_MLM); float* MS = (float*)(p.ws + OFF_MST);
    f32x4 C = {0.f, 0.f, 0.f, 0.f}; float n = 0.f, m = 0.f;
    const bool don = (part == 0 && tid < 128);
    f32x4 x = *(const f32x4*)(cl + (size_t)(bh * NCH) * 16384 + part * 2048 + tid * 4);
    for (int c = 0; c < NCH; ++c) {
        const int j = bh * NCH + c; float* cp = cl + (size_t)j * 16384 + part * 2048 + tid * 4;
        f32x4 xn = x; if (c + 1 < NCH) xn = *(const f32x4*)(cp + 16384);
        const float g = G[j], ml = ML[j];
        *(f32x4*)cp = C;
        float nx = 0.f; if (don) { nx = nl[j * 128 + tid]; nl[j * 128 + tid] = n; }
        if (part == 0 && tid == 0) MS[j] = m;
        const float mn = fmaxf(g + m, ml), dec = expf(g + m - mn), sc = expf(ml - mn);
        C = C * dec + x * sc; n = n * dec + nx * sc; m = mn; x = xn;
    }
}
__device__ void ml_pass2(const P& p, int l, int j, unsigned char* smem) {
    const int tid = lt_tid(), wid = __builtin_amdgcn_readfirstlane(tid >> 6), lane = tid & 63, ln = lane & 15, g = lane >> 4, q4 = (lane >> 2) & 3, p4 = lane & 3;
    const int bh = j / NCH, c = j % NCH, b = bh >> 2, h = bh & 3, t0 = 128 * c - 112;
    bf16_t* Ks = (bf16_t*)smem;
    bf16_t* Cs = Ks + 128 * 136;
    bf16_t* Vs = Cs + 128 * 136;
    float* fb = (float*)(Vs + 128 * 144); float* fli = fb + 128; float* fn = fli + 128;
    const bf16_t* proj = (const bf16_t*)(p.ws + OFF_PROJ);
    const bf16_t* qc = (const bf16_t*)(p.ws + OFF_QC); const bf16_t* kc = (const bf16_t*)(p.ws + OFF_KC);
    const float* cst = (const float*)(p.ws + OFF_CLOC) + (size_t)j * 16384;
#pragma unroll
    for (int it = 0; it < 4; ++it) { const int id = tid + 512 * it, s = id >> 4, dg = id & 15, t = t0 + s;
        uint4 kk = make_uint4(0, 0, 0, 0), vv = kk;
        if (t >= 0) { kk = *(const uint4*)(kc + (size_t)(b * LT + t) * 512 + h * 128 + dg * 8); vv = *(const uint4*)(proj + (size_t)(b * LT + t) * NPROJ + C_MLV + h * 128 + dg * 8); }
        *(uint4*)(Ks + s * 136 + dg * 8) = kk; *(uint4*)(Vs + s * 144 + dg * 8) = vv;
        const f32x4 c0 = *(const f32x4*)(cst + s * 128 + dg * 8), c1 = *(const f32x4*)(cst + s * 128 + dg * 8 + 4);
        u32x4 o; o.x = pk2(c0[0], c0[1]); o.y = pk2(c0[2], c0[3]); o.z = pk2(c1[0], c1[1]); o.w = pk2(c1[2], c1[3]); *(u32x4*)(Cs + s * 136 + dg * 8) = o; }
    if (tid < 128) { fb[tid] = ((const float*)(p.ws + OFF_BCUM))[bh * LPF + 128 * c + tid]; fli[tid] = ((const float*)(p.ws + OFF_MLI))[bh * LPF + 128 * c + tid]; fn[tid] = ((const float*)(p.ws + OFF_NLOC))[j * 128 + tid]; }
    const float mst = ((const float*)(p.ws + OFF_MST))[j];
    __syncthreads();
    const int tl = 16 * wid + ln, tq = t0 + tl;
    if (t0 + 16 * wid >= 0) {
        const size_t r = (size_t)(b * LT + tq);
        bf16x8 qf[4];
#pragma unroll
        for (int ks = 0; ks < 4; ++ks) qf[ks] = *(const bf16x8*)(qc + r * 512 + h * 128 + 32 * ks + 8 * g);
        const float bt = fb[tl];
        f32x4 sc[8]; float mx = NEGB;
#pragma unroll
        for (int mt = 0; mt < 8; ++mt) { sc[mt] = (f32x4){0.f, 0.f, 0.f, 0.f};
            if (mt <= wid) {
#pragma unroll
                for (int ks = 0; ks < 4; ++ks) { const bf16x8 a = *(const bf16x8*)(Ks + (16 * mt + ln) * 136 + 32 * ks + 8 * g); sc[mt] = MFMA16(a, qf[ks], sc[mt]); }
            } }
        f32x4 dl[8];
#pragma unroll
        for (int mt = 0; mt < 8; ++mt) { dl[mt] = (f32x4){NEGB, NEGB, NEGB, NEGB};
            if (mt <= wid) { const f32x4 bsv = *(const f32x4*)(fb + 16 * mt + 4 * g), liv = *(const f32x4*)(fli + 16 * mt + 4 * g);
#pragma unroll
                for (int jj = 0; jj < 4; ++jj) { const int s = 16 * mt + 4 * g + jj; const float d = (s <= tl) ? (bt - bsv[jj] + liv[jj]) : NEGB; dl[mt][jj] = d; mx = fmaxf(mx, d); } } }
        mx = fmaxf(mx, __shfl_xor(mx, 16)); mx = fmaxf(mx, __shfl_xor(mx, 32));
        const float minter = bt + mst, mcomb = fmaxf(minter, mx), iw = expf(minter - mcomb);
        float dsum = 0.f;
#pragma unroll
        for (int mt = 0; mt < 8; ++mt)
#pragma unroll
            for (int jj = 0; jj < 4; ++jj) { const float w = sc[mt][jj] * expf(dl[mt][jj] - mcomb); sc[mt][jj] = w; dsum += w; }
        f32x4 acc[8];
#pragma unroll
        for (int vt = 0; vt < 8; ++vt) { acc[vt] = (f32x4){0.f, 0.f, 0.f, 0.f};
#pragma unroll
            for (int ks = 0; ks < 4; ++ks) { const bf16x8 a = *(const bf16x8*)(Cs + (16 * vt + ln) * 136 + 32 * ks + 8 * g); acc[vt] = MFMA16(a, qf[ks], acc[vt]); }
            acc[vt] = acc[vt] * iw; }
        float qn = 0.f;
#pragma unroll
        for (int ks = 0; ks < 4; ++ks)
#pragma unroll
            for (int i = 0; i < 8; ++i) qn = fmaf(bf2f((unsigned short)qf[ks][i]), fn[32 * ks + 8 * g + i], qn);
#pragma unroll
        for (int a = 0; a < 4; ++a) {
            if (2 * a <= wid) {
                u32x4 w; w.x = pk2(sc[2 * a][0], sc[2 * a][1]); w.y = pk2(sc[2 * a][2], sc[2 * a][3]); w.z = pk2(sc[2 * a + 1][0], sc[2 * a + 1][1]); w.w = pk2(sc[2 * a + 1][2], sc[2 * a + 1][3]);
                const bf16x8 pb = *(bf16x8*)&w;
                const int r0 = 32 * a + 4 * g + q4;
#pragma unroll
                for (int vt = 0; vt < 8; ++vt) { const bf16x8 af = cat8(trrd(Vs + r0 * 144 + 16 * vt + 4 * p4), trrd(Vs + (r0 + 16) * 144 + 16 * vt + 4 * p4)); acc[vt] = MFMA16(af, pb, acc[vt]); }
            } }
        dsum += __shfl_xor(dsum, 16); dsum += __shfl_xor(dsum, 32); qn += __shfl_xor(qn, 16); qn += __shfl_xor(qn, 32);
        const float den = dsum + iw * qn, dnm = 1.f / fmaxf(fabsf(den), expf(-mcomb));
        float ss = 0.f;
#pragma unroll
        for (int vt = 0; vt < 8; ++vt) { acc[vt] = acc[vt] * dnm; ss += acc[vt][0] * acc[vt][0] + acc[vt][1] * acc[vt][1] + acc[vt][2] * acc[vt][2] + acc[vt][3] * acc[vt][3]; }
        ss += __shfl_xor(ss, 16); ss += __shfl_xor(ss, 32);
        const float rs = rsqrtf(ss * (1.f / 128.f) + EPS);
        bf16_t* yo = (bf16_t*)(p.ws + OFF_ABUF) + r * DM + 512 + h * 128;
        const float* ng = p.in[I_NORMG] + l * 512 + h * 128;
#pragma unroll
        for (int vt = 0; vt < 8; ++vt) { const int v0 = 16 * vt + 4 * g; const f32x4 gg = *(const f32x4*)(ng + v0);
            const uint2 ow = *(const uint2*)(proj + r * NPROJ + C_MLO + h * 128 + v0);
            const float o0 = sigm(__uint_as_float(ow.x << 16)), o1 = sigm(__uint_as_float(ow.x & 0xffff0000u)), o2 = sigm(__uint_as_float(ow.y << 16)), o3 = sigm(__uint_as_float(ow.y & 0xffff0000u));
            uint2 w; w.x = pk2(acc[vt][0] * rs * gg[0] * o0, acc[vt][1] * rs * gg[1] * o1); w.y = pk2(acc[vt][2] * rs * gg[2] * o2, acc[vt][3] * rs * gg[3] * o3);
            *(uint2*)(yo + v0) = w; }
    }
    __syncthreads();
}

__device__ void fox_job(const P& p, int bh, int c, unsigned char* smem) {
    const int tid = lt_tid(), wid = __builtin_amdgcn_readfirstlane(tid >> 6), lane = tid & 63, ln = lane & 15, g = lane >> 4, q4 = (lane >> 2) & 3, p4 = lane & 3;
    const int b = bh >> 2, h = bh & 3;
    bf16_t* Ks = (bf16_t*)smem;
    bf16_t* Vs = Ks + 2 * 64 * 136;
    float* ck = (float*)(Vs + 2 * 64 * 144);
    const bf16_t* proj = (const bf16_t*)(p.ws + OFF_PROJ); const float* cum = (const float*)(p.ws + OFF_CUM) + bh * LPF;
    const int tq = 128 * c - 112 + 16 * wid + ln, tqc = max(tq, 0);
    const bool wvalid = (128 * c - 112 + 16 * wid) >= 0;
    bf16x8 qf[4];
#pragma unroll
    for (int ks = 0; ks < 4; ++ks) qf[ks] = *(const bf16x8*)(proj + (size_t)(b * LT + tqc) * NPROJ + C_FXQ + h * 128 + 32 * ks + 8 * g);
    const float ct = cum[112 + tqc] * LOG2E;
    constexpr float C2 = 0.08838834764831845f * LOG2E;
    f32x4 acc[8];
#pragma unroll
    for (int vt = 0; vt < 8; ++vt) acc[vt] = (f32x4){0.f, 0.f, 0.f, 0.f};
    float m = -1e30f, lsum = 0.f;
    const int nkt = 2 * c + 1;
    uint4 kr0, kr1, vr0, vr1; float cr = 0.f;
    const int srow0 = tid >> 4, srow1 = srow0 + 32, sch = tid & 15;
#define FOX_GLOAD(kt) do { const int t_0 = max(64 * (kt) - 112 + srow0, 0), t_1 = max(64 * (kt) - 112 + srow1, 0); \
        const bf16_t* base0 = proj + (size_t)(b * LT + t_0) * NPROJ + h * 128 + sch * 8; const bf16_t* base1 = proj + (size_t)(b * LT + t_1) * NPROJ + h * 128 + sch * 8; \
        kr0 = *(const uint4*)(base0 + C_FXK); vr0 = *(const uint4*)(base0 + C_FXV); kr1 = *(const uint4*)(base1 + C_FXK); vr1 = *(const uint4*)(base1 + C_FXV); \
        if (tid < 64) cr = -cum[64 * (kt) + tid] * LOG2E; } while (0)
#define FOX_LSTORE(buf) do { *(uint4*)(Ks + ((buf) * 64 + srow0) * 136 + sch * 8) = kr0; *(uint4*)(Vs + ((buf) * 64 + srow0) * 144 + sch * 8) = vr0; \
        *(uint4*)(Ks + ((buf) * 64 + srow1) * 136 + sch * 8) = kr1; *(uint4*)(Vs + ((buf) * 64 + srow1) * 144 + sch * 8) = vr1; if (tid < 64) ck[(buf) * 64 + tid] = cr; } while (0)
    FOX_GLOAD(1); FOX_LSTORE(0);
    __syncthreads();
    for (int kt = 1; kt <= nkt; ++kt) {
        const int buf = (kt - 1) & 1;
        if (kt < nkt) FOX_GLOAD(kt + 1);
        if (wvalid && (64 * kt <= 128 * c + 16 * wid + 15)) {
            f32x4 sc[4];
#pragma unroll
            for (int mt = 0; mt < 4; ++mt) { sc[mt] = (f32x4){0.f, 0.f, 0.f, 0.f};
#pragma unroll
                for (int ks = 0; ks < 4; ++ks) { const bf16x8 a = *(const bf16x8*)(Ks + (buf * 64 + 16 * mt + ln) * 136 + 32 * ks + 8 * g); sc[mt] = MFMA16(a, qf[ks], sc[mt]); } }
            const bool domask = (kt >= 2 * c) || (kt == 1);
            float mx = -__builtin_inff();
#pragma unroll
            for (int mt = 0; mt < 4; ++mt) { const f32x4 cv = *(const f32x4*)(ck + buf * 64 + 16 * mt + 4 * g);
#pragma unroll
                for (int jj = 0; jj < 4; ++jj) { float v = fmaf(sc[mt][jj], C2, ct + cv[jj]);
                    if (domask) { const int kt_t = 64 * kt + 16 * mt + 4 * g + jj - 112; if (kt_t < 0 || kt_t > tq) v = -__builtin_inff(); }
                    sc[mt][jj] = v; mx = fmaxf(mx, v); } }
            mx = fmaxf(mx, __shfl_xor(mx, 16)); mx = fmaxf(mx, __shfl_xor(mx, 32));
            const float mn = fmaxf(m, mx), alpha = __builtin_amdgcn_exp2f(m - mn); m = mn;
            float ps = 0.f;
#pragma unroll
            for (int mt = 0; mt < 4; ++mt)
#pragma unroll
                for (int jj = 0; jj < 4; ++jj) { const float e = __builtin_amdgcn_exp2f(sc[mt][jj] - mn); sc[mt][jj] = e; ps += e; }
            lsum = lsum * alpha + ps;
#pragma unroll
            for (int vt = 0; vt < 8; ++vt) acc[vt] = acc[vt] * alpha;
#pragma unroll
            for (int a = 0; a < 2; ++a) {
                u32x4 w; w.x = pk2(sc[2 * a][0], sc[2 * a][1]); w.y = pk2(sc[2 * a][2], sc[2 * a][3]); w.z = pk2(sc[2 * a + 1][0], sc[2 * a + 1][1]); w.w = pk2(sc[2 * a + 1][2], sc[2 * a + 1][3]);
                const bf16x8 pb = *(bf16x8*)&w;
                const int r0 = buf * 64 + 32 * a + 4 * g + q4;
#pragma unroll
                for (int vt = 0; vt < 8; ++vt) { const bf16x8 af = cat8(trrd(Vs + r0 * 144 + 16 * vt + 4 * p4), trrd(Vs + (r0 + 16) * 144 + 16 * vt + 4 * p4)); acc[vt] = MFMA16(af, pb, acc[vt]); }
            }
        }
        if (kt < nkt) FOX_LSTORE(buf ^ 1);
        __syncthreads();
    }
#undef FOX_GLOAD
#undef FOX_LSTORE
    if (wvalid) {
        lsum += __shfl_xor(lsum, 16); lsum += __shfl_xor(lsum, 32);
        const float inv = 1.f / lsum;
        bf16_t* yo = (bf16_t*)(p.ws + OFF_ABUF) + (size_t)(b * LT + tq) * DM + 1024 + h * 128;
#pragma unroll
        for (int vt = 0; vt < 8; ++vt) { uint2 w; w.x = pk2(acc[vt][0] * inv, acc[vt][1] * inv); w.y = pk2(acc[vt][2] * inv, acc[vt][3] * inv); *(uint2*)(yo + 16 * vt + 4 * g) = w; }
    }
}

__device__ void phase_m1(const P& p, int l, unsigned char* smem) {
    for (int jb = blockIdx.x; jb < 1586; jb += gridDim.x) {
        if (jb < 16) fox_cum(p, l, jb);
        else if (jb < 544) ml_pass1(p, l, jb - 16, smem);
        else if (jb < 1072) s5_pass1(p, l, jb - 544);
        else pool_pre(p, jb - 1072);
    }
}
__device__ void phase_m2(const P& p, int l) {
    for (int jb = blockIdx.x; jb < 144; jb += gridDim.x) { if (jb < 128) ml_scan(p, jb); else s5_carry(p, l, jb - 128); }
}
__device__ void phase_m3(const P& p, int l, unsigned char* smem) {
    __shared__ int s_job;
    unsigned* ctr = (unsigned*)(p.ws + OFF_CTR) + l;
    for (;;) {
        if (lt_tid() == 0) s_job = (int)atomicAdd(ctr, 1u);
        __syncthreads();
        const int jb = s_job;
        __syncthreads();
        if (jb >= 1584) break;
        if (jb < 528) fox_job(p, jb & 15, 32 - (jb >> 4), smem);
        else if (jb < 1056) ml_pass2(p, l, jb - 528, smem);
        else { s5_pass2(p, l, jb - 1056, smem); __syncthreads(); }
    }
}

__global__ __launch_bounds__(512, 2) void mega(P p, int ph0, int ph1) {
    extern __shared__ __attribute__((aligned(16))) unsigned char smem[];
    cg::grid_group grid = cg::this_grid();
    bf16_t* abuf = (bf16_t*)(p.ws + OFF_ABUF); bf16_t* fbuf = (bf16_t*)(p.ws + OFF_FBUF);
    for (int ph = ph0; ph < ph1; ++ph) {
        if (ph > ph0) grid.sync();
        if (ph == 0) {
            if (blockIdx.x == 0 && lt_tid() < 8) ((unsigned*)(p.ws + OFF_CTR))[lt_tid()] = 0u;
            convert_phase(p, 0, smem); row_first(p);
            continue;
        }
        const int l = (ph - 1) / 10, s = (ph - 1) % 10;
        switch (s) {
        case 0: { EpiG1 E; E.O = (bf16_t*)(p.ws + OFF_PROJ); E.gates = (float*)(p.ws + OFF_GATES); run_gemm(smem, abuf, (const bf16_t*)(p.ws + OFF_WIN), NIN, DM, E, 0); } break;
        case 1: phase_m1(p, l, smem); break;
        case 2: phase_m2(p, l); break;
        case 3: phase_m3(p, l, smem); break;
        case 4: { EpiGLU E; E.O = abuf; E.bias = p.in[I_GLUB] + l * 1024; run_gemm(smem, (const bf16_t*)(p.ws + OFF_SY), (const bf16_t*)(p.ws + OFF_WGLU), 1024, 512, E, 0);
                  EpiPool E2; E2.O = abuf; E2.scale = p.in[I_POOLS] + l * 512; run_gemm(smem, (const bf16_t*)(p.ws + OFF_POOLED), (const bf16_t*)(p.ws + OFF_WPOOL), 512, 512, E2, 120); } break;
        case 5: { EpiF32 E; E.C = (float*)(p.ws + OFF_FBUF); E.ldc = DM; run_gemm(smem, abuf, (const bf16_t*)(p.ws + OFF_WOUT), DM, DM, E, 0); } break;
        case 6: row_postmix(p, l); break;
        case 7: { EpiB<1> E; E.O = fbuf; E.ldc = DFF; run_gemm(smem, abuf, (const bf16_t*)(p.ws + OFF_W1), DFF, DM, E, 0); } break;
        case 8: { EpiB<0> E; E.O = abuf; E.ldc = DM; run_gemm(smem, fbuf, (const bf16_t*)(p.ws + OFF_W2), DM, DFF, E, 0); } break;
        case 9: row_postffn(p, l); if (l + 1 < DEPTH) convert_phase(p, l + 1, smem); break;
        }
    }
}

extern "C" void kernel_launch(void* const* d_in, const int* in_sizes, int n_in, void* d_out, int out_size, void* d_ws, size_t ws_size, hipStream_t stream) {
    constexpr size_t kDynLds = 131072;
    static int grid_blocks = 0;
    if (!grid_blocks) {
        hipFuncSetAttribute((const void*)mega, hipFuncAttributeMaxDynamicSharedMemorySize, (int)kDynLds);
        int dev = 0, cus = 0, per_cu = 0;
        hipGetDevice(&dev);
        hipDeviceGetAttribute(&cus, hipDeviceAttributeMultiprocessorCount, dev);
        hipOccupancyMaxActiveBlocksPerMultiprocessor(&per_cu, mega, 512, kDynLds);
        if (per_cu < 1) per_cu = 1;
        grid_blocks = cus * (per_cu > 1 ? 1 : per_cu);
    }
    P p{};
    for (int i = 0; i < N_IN; ++i) p.in[i] = (const float*)d_in[i];
    p.out = (float*)d_out; p.ws = (unsigned char*)d_ws;
    int ph0 = 0, ph1 = 1 + 10 * DEPTH;
    void* args[] = {&p, &ph0, &ph1};
    hipError_t e = hipLaunchCooperativeKernel((const void*)mega, dim3(grid_blocks), dim3(512), args, kDynLds, stream);
    if (e != hipSuccess) fprintf(stderr, "cooperative launch failed: %s (grid %d)\n", hipGetErrorString(e), grid_blocks);
}
```

```cpp
#include <hip/hip_runtime.h>
#include <hip/hip_cooperative_groups.h>
#include <cstdio>
namespace cg = cooperative_groups;

__device__ __forceinline__ int lt_tid() { int t = threadIdx.x; asm volatile("" : "+v"(t)); return t; }
namespace pg8 {
#define PG8_LAS __attribute__((address_space(3)))
typedef unsigned short bf16_t;
typedef short bf16x8 __attribute__((ext_vector_type(8)));
typedef float f32x4 __attribute__((ext_vector_type(4)));
typedef unsigned u32x4 __attribute__((ext_vector_type(4)));
constexpr int BM = 256, BK = 64, HALF = 128, HTB = HALF * BK * 2  , STAGE_BYTES = 8 * HTB, NXCD = 8, WGM = 4  ;

__host__ __device__ __forceinline__ int lds_byte(int r, int c) { const int st = (r >> 4) * 2 + (c >> 5), rr = r & 15, cc = c & 31, ob = rr * 64 + cc * 2; return st * 1024 + (ob ^ (((ob >> 9) & 1) << 5)); }
__host__ __device__ __forceinline__ void stage_rc(int b, int& R, int& C) { const int st = b / 1024, sb = b % 1024, swz = sb ^ (((sb >> 9) & 1) << 5); R = (st >> 1) * 16 + swz / 64; C = (st & 1) * 32 + (swz % 64) / 2; }
__host__ __device__ __forceinline__ int perm32(int rho) { const int n = rho >> 4, i = rho & 15; return 8 * (i >> 2) + 4 * n + (i & 3); }

struct Unit { int pm, pn; };
struct Gemm { const bf16_t* A; const bf16_t* Bt; int M, N, K; };

struct StaticOrder {
    int nM, nN, nwg, G, c;
    __host__ __device__ void init(int M, int N, int G_, int c_) { nM = M / BM; nN = N / BM; nwg = nM * nN; G = G_; c = c_; }
    __host__ __device__ bool next(int i, Unit& u) const {
        const long L = (long)i * G + c; if (L >= nwg) return false;
        int wgid = (int)L; { const int q = nwg / NXCD, r = nwg % NXCD, xcd = wgid % NXCD, off = wgid / NXCD; wgid = (xcd < r ? xcd * (q + 1) : r * (q + 1) + (xcd - r) * q) + off; }
        const int nig = WGM * nN, gid = wgid / nig, fm = gid * WGM, gsz = (nM - fm) < WGM ? (nM - fm) : WGM;
        u.pm = fm + ((wgid % nig) % gsz); u.pn = (wgid % nig) / gsz; return true;
    }
    __device__ __forceinline__ void a_ready(const Unit&) const {}
    __device__ __forceinline__ void done(const Unit&) const {}
};
__device__ __forceinline__ unsigned cvt_pk_bf16(float lo, float hi) { unsigned r; asm volatile("v_cvt_pk_bf16_f32 %0, %1, %2" : "=v"(r) : "v"(lo), "v"(hi)); return r; }

template <class Epi, class Sched, bool STAMP = false>
__device__ __forceinline__ void gemm_phase(PG8_LAS unsigned char* lds, const Gemm g, const Sched& S, const Epi& E, unsigned long long* stamps) {
    const int tid = lt_tid(), wid = __builtin_amdgcn_readfirstlane(tid >> 6), lane = tid & 63, wr = wid >> 2, wc = wid & 3, fr = lane & 15, fq = lane >> 4;
    const int K = g.K, nt = K / BK;
    int ts_lo = 0, ts_hi = 0, nts = 0; const unsigned long long rt_entry = STAMP ? (unsigned long long)wall_clock64() : 0ull;
#define PG8_STAMP() do { if (STAMP && wid == 0 && nts < 64) { const unsigned long long _c = (unsigned long long)clock64(); \
        ts_lo = (lane == nts) ? (int)(unsigned)_c : ts_lo; ts_hi = (lane == nts) ? (int)(unsigned)(_c >> 32) : ts_hi; ++nts; } } while (0)
    PG8_STAMP();
    unsigned voffA[2], voffB[2];
#pragma unroll
    for (int i = 0; i < 2; ++i) { int R, C; stage_rc(tid * 16 + i * 8192, R, C); const int Rb = Epi::PERM ? ((R & ~31) + perm32(R & 31)) : R;
        voffA[i] = (unsigned)(R * K + C) * 2u; voffB[i] = (unsigned)(Rb * K + C) * 2u; }
    const size_t kstep = (size_t)(BK * 2);
    const size_t hstep = (size_t)HALF * K * 2;
    const size_t tstep = 2 * hstep;
    const unsigned ldsw = (unsigned)wid * 1024u;
    const int aoff = lds_byte(wr * 64 + fr, fq * 8), boff = lds_byte(wc * 32 + fr, fq * 8);
#define PG8_SA(b, h) (((b) * 2 + (h)) * HTB)
#define PG8_SB(b, h) ((4 + (b) * 2 + (h)) * HTB)
#define PG8_STAGE(bufoff, gbase, voff) do { _Pragma("unroll") for (int _i = 0; _i < 2; ++_i) \
        __builtin_amdgcn_global_load_lds((const unsigned*)((const char*)(gbase) + (voff)[_i]), (PG8_LAS unsigned*)(lds + (bufoff) + ldsw + _i * 8192), 16, 0, 0); } while (0)
#define PG8_LDA(dst, b, h) do { _Pragma("unroll") for (int m = 0; m < 4; ++m) _Pragma("unroll") for (int k = 0; k < 2; ++k) dst[m][k] = *(const PG8_LAS bf16x8*)(lds + PG8_SA(b, h) + aoff + m * 2048 + k * 1024); } while (0)
#define PG8_LDB(dst, b, h) do { _Pragma("unroll") for (int n = 0; n < 2; ++n) _Pragma("unroll") for (int k = 0; k < 2; ++k) dst[n][k] = *(const PG8_LAS bf16x8*)(lds + PG8_SB(b, h) + boff + n * 2048 + k * 1024); } while (0)
#define PG8_MMA(ai, bj, At, Bt) do { __builtin_amdgcn_s_setprio(1); _Pragma("unroll") for (int m = 0; m < 4; ++m) _Pragma("unroll") for (int n = 0; n < 2; ++n) _Pragma("unroll") for (int k = 0; k < 2; ++k) \
        acc[ai][bj][m][n] = __builtin_amdgcn_mfma_f32_16x16x32_bf16(Bt[n][k], At[m][k], acc[ai][bj][m][n], 0, 0, 0); __builtin_amdgcn_s_setprio(0); } while (0)
#define PG8_WAIT_V(n) asm volatile("s_waitcnt vmcnt(" #n ")" ::: "memory")
#define PG8_WAIT_L(n) asm volatile("s_waitcnt lgkmcnt(" #n ")" ::: "memory")
#define PG8_BAR __builtin_amdgcn_s_barrier()
#define PG8_SCHED __builtin_amdgcn_sched_barrier(0)
    Unit cur, nxt; int ui = 0;
    if (!S.next(0, cur)) return;
    f32x4 acc[2][2][4][2];
#pragma unroll
    for (int a = 0; a < 2; ++a)
#pragma unroll
        for (int b = 0; b < 2; ++b)
#pragma unroll
            for (int m = 0; m < 4; ++m)
#pragma unroll
                for (int n = 0; n < 2; ++n) acc[a][b][m][n] = (f32x4){0.f, 0.f, 0.f, 0.f};
    bf16x8 At[4][2], B0[2][2], B1[2][2];
    const char* cA = (const char*)g.A + (size_t)cur.pm * tstep; const char* cB = (const char*)g.Bt + (size_t)cur.pn * tstep;
    S.a_ready(cur);
    PG8_STAGE(PG8_SB(0, 0), cB, voffB); PG8_STAGE(PG8_SA(0, 0), cA, voffA); PG8_STAGE(PG8_SB(0, 1), cB + hstep, voffB); PG8_STAGE(PG8_SA(0, 1), cA + hstep, voffA);
    if (wr == 1) PG8_BAR;
    PG8_WAIT_V(4); PG8_BAR;
    PG8_STAGE(PG8_SB(1, 0), cB + kstep, voffB); PG8_STAGE(PG8_SA(1, 0), cA + kstep, voffA); PG8_STAGE(PG8_SB(1, 1), cB + hstep + kstep, voffB);
    PG8_WAIT_V(6); PG8_BAR;
    PG8_STAMP();
    for (;;) {
        const bool has_next = S.next(ui + 1, nxt);
        const char* nA = has_next ? (const char*)g.A + (size_t)nxt.pm * tstep : cA; const char* nB = has_next ? (const char*)g.Bt + (size_t)nxt.pn * tstep : cB;
        for (int t = 0; t < nt; t += 2) {
            const bool last = (t == nt - 2);
            const char* a1 = cA + (size_t)(t + 1) * kstep;
            const char* a2 = last ? nA : cA + (size_t)(t + 2) * kstep; const char* b2 = last ? nB : cB + (size_t)(t + 2) * kstep;
            const char* a3 = a2 + kstep; const char* b3 = b2 + kstep;
            if (last && has_next) S.a_ready(nxt);
            PG8_LDB(B0, 0, 0); PG8_SCHED; PG8_LDA(At, 0, 0); PG8_STAGE(PG8_SA(1, 1), a1 + hstep, voffA);
            PG8_WAIT_L(8); PG8_BAR; PG8_WAIT_L(0); PG8_MMA(0, 0, At, B0); PG8_BAR; PG8_SCHED;
            PG8_LDB(B1, 0, 1); PG8_STAGE(PG8_SB(0, 0), b2, voffB);
            PG8_BAR; PG8_WAIT_L(0); PG8_MMA(0, 1, At, B1); PG8_BAR;
            PG8_LDA(At, 0, 1); PG8_STAGE(PG8_SA(0, 0), a2, voffA);
            PG8_BAR; PG8_WAIT_L(0); PG8_MMA(1, 0, At, B0); PG8_BAR; PG8_SCHED;
            PG8_STAGE(PG8_SB(0, 1), b2 + hstep, voffB);
            PG8_WAIT_V(6); PG8_BAR; PG8_MMA(1, 1, At, B1); PG8_BAR;
            PG8_LDB(B0, 1, 0); PG8_SCHED; PG8_LDA(At, 1, 0); PG8_STAGE(PG8_SA(0, 1), a2 + hstep, voffA);
            PG8_WAIT_L(8); PG8_BAR; PG8_WAIT_L(0); PG8_MMA(0, 0, At, B0); PG8_BAR; PG8_SCHED;
            PG8_LDB(B1, 1, 1); PG8_STAGE(PG8_SB(1, 0), b3, voffB);
            PG8_BAR; PG8_WAIT_L(0); PG8_MMA(0, 1, At, B1); PG8_BAR;
            PG8_LDA(At, 1, 1); PG8_STAGE(PG8_SA(1, 0), a3, voffA);
            PG8_BAR; PG8_WAIT_L(0); PG8_MMA(1, 0, At, B0); PG8_BAR; PG8_SCHED;
            PG8_STAGE(PG8_SB(1, 1), b3 + hstep, voffB);
            PG8_WAIT_V(6); PG8_BAR; PG8_MMA(1, 1, At, B1); PG8_BAR;
        }
        PG8_STAMP();
        if constexpr (!Epi::AFTER_DRAIN) { E(acc, cur, wr, wc, fr, fq); S.done(cur); }
        PG8_STAMP();
        if (!has_next) break;
#pragma unroll
        for (int a = 0; a < 2; ++a)
#pragma unroll
            for (int b = 0; b < 2; ++b)
#pragma unroll
                for (int m = 0; m < 4; ++m)
#pragma unroll
                    for (int n = 0; n < 2; ++n) acc[a][b][m][n] = (f32x4){0.f, 0.f, 0.f, 0.f};
        cur = nxt; cA = nA; cB = nB; ++ui;
    }
    PG8_WAIT_V(0);
    if (wr == 0) PG8_BAR;
    PG8_BAR;
    if constexpr (Epi::AFTER_DRAIN) { E.fused(acc, cur, wr, wc, fr, fq, lds, wid, lane); S.done(cur); }
    PG8_STAMP();
    if (STAMP && wid == 0) { stamps[lane] = lane < nts ? (((unsigned long long)(unsigned)ts_hi << 32) | (unsigned)ts_lo) : 0ull;
        if (lane == 62) stamps[62] = rt_entry; if (lane == 63) stamps[63] = (unsigned long long)wall_clock64(); }
#undef PG8_STAMP
#undef PG8_SA
#undef PG8_SB
#undef PG8_STAGE
#undef PG8_LDA
#undef PG8_LDB
#undef PG8_MMA
#undef PG8_WAIT_V
#undef PG8_WAIT_L
#undef PG8_BAR
#undef PG8_SCHED
}
}

using pg8::bf16_t; using pg8::bf16x8; using pg8::f32x4; using pg8::u32x4;
typedef short s16x4 __attribute__((ext_vector_type(4)));
#define LAS3 __attribute__((address_space(3)))

constexpr int NB = 4, LT = 4112, DM = 2048, MR = NB * LT  , MP = 16640, NMAIN = 16384, NCH = 33, LPF = 4224;
constexpr int NPROJ = 3584, NIN = 4864, DFF = 8192, DEPTH = 2;
constexpr int C_S5U = 0, C_MLQ = 512, C_MLK = 1024, C_MLV = 1536, C_MLO = 2048, C_FXQ = 2560, C_PLU = 3072;
constexpr float EPS = 1e-6f, NEGB = -1e30f, LOG2E = 1.4426950408889634f;

enum { I_X = 0, I_META, I_GPREMIX, I_GPOSTMIX, I_GPREFFN, I_GPOSTFFN, I_WIN, I_MLGB, I_FXGB, I_LRE, I_LIM, I_LOGDT, I_BRE, I_BIM,
       I_CRE, I_CIM, I_SD, I_GLUW, I_GLUB, I_CONVW, I_NORMG, I_POOLW, I_POOLS, I_WOUT, I_W1, I_W2, N_IN };
struct P { const float* in[N_IN]; float* out; unsigned char* ws; };

constexpr size_t AL(size_t x) { return (x + 255) & ~(size_t)255; }
constexpr size_t OFF_WIN = 0;
constexpr size_t OFF_WOUT = OFF_WIN + AL((size_t)NIN * DM * 2);
constexpr size_t OFF_W1 = OFF_WOUT + AL((size_t)DM * DM * 2);
constexpr size_t OFF_W2 = OFF_W1 + AL((size_t)DFF * DM * 2);
constexpr size_t OFF_WGLU = OFF_W2 + AL((size_t)DM * DFF * 2);
constexpr size_t OFF_WPOOL = OFF_WGLU + AL((size_t)1024 * 512 * 2);
constexpr size_t OFF_ABUF = OFF_WPOOL + AL((size_t)512 * 512 * 2);
constexpr size_t OFF_FBUF = OFF_ABUF + AL((size_t)MP * DM * 2);
constexpr size_t OFF_PROJ = OFF_FBUF;
constexpr size_t OFF_QC = OFF_PROJ + AL((size_t)MP * NPROJ * 2);
constexpr size_t OFF_KC = OFF_QC + AL((size_t)MR * 512 * 2);
constexpr size_t OFF_CLOC = OFF_KC + AL((size_t)MR * 512 * 2);
constexpr size_t OFF_SY = OFF_CLOC + AL((size_t)528 * 16384 * 4);
constexpr size_t OFF_POOLED = OFF_SY + AL((size_t)MP * 512 * 2);
constexpr size_t OFF_FK = OFF_POOLED + AL((size_t)MP * 512 * 2);
constexpr size_t OFF_FV = OFF_FK + AL((size_t)16 * LT * 128 * 2);
constexpr size_t OFF_FEND = OFF_FV + AL((size_t)16 * LT * 128 * 2);
constexpr size_t OFF_SMALL = OFF_FBUF + AL((size_t)MP * DFF * 2);
static_assert(OFF_FEND <= OFF_SMALL, "mixer scratch must fit inside FBUF");
constexpr size_t OFF_GATES = OFF_SMALL;
constexpr size_t OFF_CUM = OFF_GATES + AL((size_t)MP * 16 * 4);
constexpr size_t OFF_BCUM = OFF_CUM + AL((size_t)16 * LPF * 4);
constexpr size_t OFF_MLI = OFF_BCUM + AL((size_t)16 * LPF * 4);
constexpr size_t OFF_MLG = OFF_MLI + AL((size_t)16 * LPF * 4);
constexpr size_t OFF_MLM = OFF_MLG + AL(528 * 4);
constexpr size_t OFF_MST = OFF_MLM + AL(528 * 4);
constexpr size_t OFF_NLOC = OFF_MST + AL(528 * 4);
constexpr size_t OFF_S5E = OFF_NLOC + AL((size_t)528 * 128 * 4);
constexpr size_t OFF_S5IN = OFF_S5E + AL((size_t)NB * NCH * 2048 * 8);
constexpr size_t OFF_CTR = OFF_S5IN + AL((size_t)NB * NCH * 2048 * 8);
constexpr size_t OFF_XBAR = OFF_CTR + 512;
constexpr size_t OFF_HB = OFF_XBAR + AL(3456 * 4 + 256);
constexpr size_t OFF_END = OFF_HB + AL((size_t)MP * DM * 2);
static_assert(OFF_END <= (size_t)512 * 1024 * 1024, "workspace budget");

__device__ __forceinline__ float bf2f(unsigned short h) { return __uint_as_float(((unsigned)h) << 16); }
__device__ __forceinline__ unsigned pk2(float lo, float hi) { return pg8::cvt_pk_bf16(lo, hi); }
__device__ __forceinline__ float logsig(float x) { return fminf(x, 0.f) - log1pf(expf(-fabsf(x))); }
__device__ __forceinline__ float sigm(float x) { return 1.f / (1.f + __expf(-x)); }
__device__ __forceinline__ float wsum(float v) { for (int o = 32; o > 0; o >>= 1) v += __shfl_xor(v, o); return v; }
__device__ __forceinline__ float wmaxf(float v) { for (int o = 32; o > 0; o >>= 1) v = fmaxf(v, __shfl_xor(v, o)); return v; }
__device__ __forceinline__ int rmap(int b, int t) { return t >= 16 ? b * 4096 + (t - 16) : NMAIN + b * 16 + t; }
__device__ __forceinline__ bf16_t* hrow(const P& p, int r) { return (bf16_t*)(p.ws + OFF_HB) + (size_t)r * DM; }
__device__ __forceinline__ void st4bf(bf16_t* q, f32x4 v) { uint2 w; w.x = pk2(v[0], v[1]); w.y = pk2(v[2], v[3]); *(uint2*)q = w; }
__device__ __forceinline__ s16x4 trrd(const bf16_t* a) { return __builtin_amdgcn_ds_read_tr16_b64_v4i16((LAS3 s16x4*)a); }
__device__ __forceinline__ bf16x8 cat8(s16x4 a, s16x4 b) { return (bf16x8){a[0], a[1], a[2], a[3], b[0], b[1], b[2], b[3]}; }
#define MFMA16(A, B, C) __builtin_amdgcn_mfma_f32_16x16x32_bf16(A, B, C, 0, 0, 0)

struct EpiG1 {
    static constexpr bool PERM = true, AFTER_DRAIN = false;
    bf16_t* O; float* gates; bf16_t* fk; bf16_t* fv;
    __device__ __forceinline__ void operator()(const f32x4 (&acc)[2][2][4][2], const pg8::Unit& u, int wr, int wc, int fr_, int fq_) const {
        int fr = fr_, fq = fq_; asm volatile("" : "+v"(fr), "+v"(fq));
        const int row0 = u.pm * 256 + wr * 64 + fr;
        if (u.pn >= 12 && u.pn < 16) {
            bf16_t* dstb = (u.pn >= 14 ? fv : fk) + wc * 32 + 8 * fq; const int h0 = (u.pn & 1) * 2;
#pragma unroll
            for (int ai = 0; ai < 2; ++ai)
#pragma unroll
                for (int m = 0; m < 4; ++m) { const int r = row0 + ai * 128 + m * 16; if (r >= MR) continue;
                    const int b = r < NMAIN ? (r >> 12) : ((r - NMAIN) >> 4), t = r < NMAIN ? (r & 4095) + 16 : ((r - NMAIN) & 15);
#pragma unroll
                    for (int bj = 0; bj < 2; ++bj) { const f32x4 v0 = acc[ai][bj][m][0], v1 = acc[ai][bj][m][1];
                        u32x4 w; w.x = pk2(v0[0], v0[1]); w.y = pk2(v0[2], v0[3]); w.z = pk2(v1[0], v1[1]); w.w = pk2(v1[2], v1[3]);
                        *(u32x4*)(dstb + ((size_t)((b * 4 + h0 + bj) * LT + t)) * 128) = w; } }
        } else if (u.pn < 18) {
            const int col0 = (u.pn < 12 ? u.pn : u.pn - 4) * 256 + wc * 32 + 8 * fq;
#pragma unroll
            for (int ai = 0; ai < 2; ++ai)
#pragma unroll
                for (int m = 0; m < 4; ++m) { bf16_t* rowp = O + (size_t)(row0 + ai * 128 + m * 16) * NPROJ + col0;
#pragma unroll
                    for (int bj = 0; bj < 2; ++bj) { const f32x4 v0 = acc[ai][bj][m][0], v1 = acc[ai][bj][m][1];
                        u32x4 w; w.x = pk2(v0[0], v0[1]); w.y = pk2(v0[2], v0[3]); w.z = pk2(v1[0], v1[1]); w.w = pk2(v1[2], v1[3]);
                        *(u32x4*)(rowp + bj * 128) = w; } }
        } else if (wc == 0 && fq < 2) {
#pragma unroll
            for (int ai = 0; ai < 2; ++ai)
#pragma unroll
                for (int m = 0; m < 4; ++m) { float* gp = gates + (size_t)(row0 + ai * 128 + m * 16) * 16 + 8 * fq;
                    *(f32x4*)gp = acc[ai][0][m][0]; *(f32x4*)(gp + 4) = acc[ai][0][m][1]; }
        }
    }
};
template <int ACT> struct EpiB {
    static constexpr bool PERM = true, AFTER_DRAIN = false;
    bf16_t* O; int ldc;
    __device__ __forceinline__ void operator()(const f32x4 (&acc)[2][2][4][2], const pg8::Unit& u, int wr, int wc, int fr_, int fq_) const {
        int fr = fr_, fq = fq_; asm volatile("" : "+v"(fr), "+v"(fq));
        const int row0 = u.pm * 256 + wr * 64 + fr, col0 = u.pn * 256 + wc * 32 + 8 * fq;
#pragma unroll
        for (int ai = 0; ai < 2; ++ai)
#pragma unroll
            for (int m = 0; m < 4; ++m) { bf16_t* rowp = O + (size_t)(row0 + ai * 128 + m * 16) * ldc + col0;
#pragma unroll
                for (int bj = 0; bj < 2; ++bj) { f32x4 v0 = acc[ai][bj][m][0], v1 = acc[ai][bj][m][1];
                    if (ACT == 1) {
#pragma unroll
                        for (int j = 0; j < 4; ++j) { const float a = fmaxf(v0[j], 0.f), b = fmaxf(v1[j], 0.f); v0[j] = a * a; v1[j] = b * b; } }
                    u32x4 w; w.x = pk2(v0[0], v0[1]); w.y = pk2(v0[2], v0[3]); w.z = pk2(v1[0], v1[1]); w.w = pk2(v1[2], v1[3]);
                    *(u32x4*)(rowp + bj * 128) = w; } }
    }
};
struct EpiGLU {
    static constexpr bool PERM = true, AFTER_DRAIN = false;
    bf16_t* O; const float* bias;
    __device__ __forceinline__ void operator()(const f32x4 (&acc)[2][2][4][2], const pg8::Unit& u, int wr, int wc, int fr_, int fq_) const {
        int fr = fr_, fq = fq_; asm volatile("" : "+v"(fr), "+v"(fq));
        const int row0 = u.pm * 256 + wr * 64 + fr, oc = u.pn * 128 + wc * 32 + 8 * fq;
        const f32x4 bv0 = *(const f32x4*)(bias + oc), bv1 = *(const f32x4*)(bias + oc + 4), bg0 = *(const f32x4*)(bias + 512 + oc), bg1 = *(const f32x4*)(bias + 512 + oc + 4);
#pragma unroll
        for (int ai = 0; ai < 2; ++ai)
#pragma unroll
            for (int m = 0; m < 4; ++m) {
                f32x4 v0 = acc[ai][0][m][0] + bv0, v1 = acc[ai][0][m][1] + bv1; const f32x4 g0 = acc[ai][1][m][0] + bg0, g1 = acc[ai][1][m][1] + bg1;
#pragma unroll
                for (int j = 0; j < 4; ++j) { v0[j] *= sigm(g0[j]); v1[j] *= sigm(g1[j]); }
                u32x4 w; w.x = pk2(v0[0], v0[1]); w.y = pk2(v0[2], v0[3]); w.z = pk2(v1[0], v1[1]); w.w = pk2(v1[2], v1[3]);
                *(u32x4*)(O + (size_t)(row0 + ai * 128 + m * 16) * DM + oc) = w; }
    }
};
struct EpiPool {
    static constexpr bool PERM = true, AFTER_DRAIN = false;
    bf16_t* O; const float* scale;
    __device__ __forceinline__ void operator()(const f32x4 (&acc)[2][2][4][2], const pg8::Unit& u, int wr, int wc, int fr_, int fq_) const {
        int fr = fr_, fq = fq_; asm volatile("" : "+v"(fr), "+v"(fq));
        const int row0 = u.pm * 256 + wr * 64 + fr, col0 = u.pn * 256 + wc * 32 + 8 * fq;
#pragma unroll
        for (int bj = 0; bj < 2; ++bj) { const f32x4 s0 = *(const f32x4*)(scale + col0 + bj * 128), s1 = *(const f32x4*)(scale + col0 + bj * 128 + 4);
#pragma unroll
            for (int ai = 0; ai < 2; ++ai)
#pragma unroll
                for (int m = 0; m < 4; ++m) { const f32x4 v0 = acc[ai][bj][m][0] * s0, v1 = acc[ai][bj][m][1] * s1;
                    u32x4 w; w.x = pk2(v0[0], v0[1]); w.y = pk2(v0[2], v0[3]); w.z = pk2(v1[0], v1[1]); w.w = pk2(v1[2], v1[3]);
                    *(u32x4*)(O + (size_t)(row0 + ai * 128 + m * 16) * DM + 1536 + col0 + bj * 128) = w; } }
    }
};
struct EpiF32 {
    static constexpr bool PERM = false, AFTER_DRAIN = false;
    float* C; int ldc;
    __device__ __forceinline__ void operator()(const f32x4 (&acc)[2][2][4][2], const pg8::Unit& u, int wr, int wc, int fr_, int fq_) const {
        int fr = fr_, fq = fq_; asm volatile("" : "+v"(fr), "+v"(fq));
        const int row0 = u.pm * 256 + wr * 64 + fr, col0 = u.pn * 256 + wc * 32 + 4 * fq;
#pragma unroll
        for (int ai = 0; ai < 2; ++ai)
#pragma unroll
            for (int m = 0; m < 4; ++m) { float* rowp = C + (size_t)(row0 + ai * 128 + m * 16) * ldc + col0;
#pragma unroll
                for (int bj = 0; bj < 2; ++bj)
#pragma unroll
                    for (int n = 0; n < 2; ++n) *(f32x4*)(rowp + bj * 128 + n * 16) = acc[ai][bj][m][n]; }
    }
};
template <class Epi> __device__ __forceinline__ void run_gemm(unsigned char* smem, const bf16_t* A, const bf16_t* Bt, int N, int K, const Epi& E, int cshift, int Mrows = MP) {
    pg8::Gemm g; g.A = A; g.Bt = Bt; g.M = Mrows; g.N = N; g.K = K;
    int G_ = gridDim.x; asm volatile("" : "+s"(G_));
    int c_ = blockIdx.x + cshift; if (c_ >= G_) c_ -= G_;
    pg8::StaticOrder S; S.init(Mrows, N, G_, c_);
    pg8::gemm_phase<Epi, pg8::StaticOrder, false>((PG8_LAS unsigned char*)smem, g, S, E, nullptr);
}


template <int MODE>
__device__ void skinny_meta(unsigned char* smem, const bf16_t* A, const bf16_t* Bt, int N, int K, void* out) {
    float* red = (float*)smem;
    const int tid = lt_tid(), wid = tid >> 6, lane = tid & 63, ln = lane & 15, g = lane >> 4;
    const int kw = K >> 3, k0 = wid * kw;
    const bf16_t* a0 = A + (size_t)(NMAIN + ln) * K + k0 + 8 * g;
    for (int grp = blockIdx.x; grp < (N >> 4); grp += gridDim.x) {
        const bf16_t* b0 = Bt + (size_t)(grp * 16 + ln) * K + k0 + 8 * g;
        f32x4 acc = {0.f, 0.f, 0.f, 0.f};
#pragma unroll 4
        for (int ks = 0; ks < (kw >> 5); ++ks) { const bf16x8 a = *(const bf16x8*)(a0 + 32 * ks), b = *(const bf16x8*)(b0 + 32 * ks); acc = MFMA16(a, b, acc); }
#pragma unroll
        for (int j = 0; j < 4; ++j) red[wid * 256 + (4 * g + j) * 16 + ln] = acc[j];
        __syncthreads();
        if (tid < 256) { float v = 0.f;
#pragma unroll
            for (int w = 0; w < 8; ++w) v += red[w * 256 + tid];
            const int r = tid >> 4, col = grp * 16 + (tid & 15);
#pragma unroll
            for (int b = 0; b < 4; ++b) { const size_t row = NMAIN + b * 16 + r;
                if (MODE == 0) ((float*)out)[row * DM + col] = v;
                else if (MODE == 1) { const float a = fmaxf(v, 0.f); ((bf16_t*)out)[row * DFF + col] = (bf16_t)(pk2(a * a, 0.f) & 0xffffu); }
                else ((bf16_t*)out)[row * DM + col] = (bf16_t)(pk2(v, 0.f) & 0xffffu); } }
        __syncthreads();
    }
}

__device__ __forceinline__ f32x4 wload4(int mode, const float* src, int k, int n) {
    const f32x4 z = {0.f, 0.f, 0.f, 0.f};
    if (mode == 0) {
        int c;
        if (n < 4608) c = n + (n >= 2560 ? 8 : 0) + (n >= 4096 ? 4 : 0);
        else if (n < 4608 + 8) c = 2560 + (n - 4608);
        else if (n < 4608 + 12) c = 4104;
        else return z;
        return __builtin_nontemporal_load((const f32x4*)(src + (size_t)k * 4620 + c));
    } else if (mode == 1) { return __builtin_nontemporal_load((const f32x4*)(src + (size_t)k * DM + n)); }
    else if (mode == 2) { return __builtin_nontemporal_load((const f32x4*)(src + (size_t)k * DFF + n)); }
    else if (mode == 3) { const int pn = n >> 8, i = n & 255; const int c = i < 128 ? pn * 128 + i : 512 + pn * 128 + (i - 128); return __builtin_nontemporal_load((const f32x4*)(src + (size_t)k * 1024 + c)); }
    else { const int g = n >> 7; return (k >> 7) == g ? __builtin_nontemporal_load((const f32x4*)(src + ((size_t)g * 128 + (k & 127)) * 128 + (n & 127))) : z; }
}
__device__ void convert_phase(const P& p, int l, unsigned char* smem) {
    float* tile = (float*)smem;
    const int tid = lt_tid();
    const int nt0 = (NIN / 64) * 8, nt1 = 32 * 8, nt2 = 128 * 8, nt3 = 32 * 32, nt4 = 16 * 2, nt5 = 8 * 2;
    const int total = nt0 + nt1 + nt2 + nt3 + nt4 + nt5;
    auto decode = [&](int tI, int& mode, int& K, const float*& src, bf16_t*& dst, int& k0, int& n0) {
        int x = tI;
        if (x < nt0) { mode = 0; K = 2048; src = p.in[I_WIN] + (size_t)l * DM * 4620; dst = (bf16_t*)(p.ws + OFF_WIN); }
        else if ((x -= nt0) < nt1) { mode = 1; K = 2048; src = p.in[I_WOUT] + (size_t)l * DM * DM; dst = (bf16_t*)(p.ws + OFF_WOUT); }
        else if ((x -= nt1) < nt2) { mode = 2; K = 2048; src = p.in[I_W1] + (size_t)l * DM * DFF; dst = (bf16_t*)(p.ws + OFF_W1); }
        else if ((x -= nt2) < nt3) { mode = 1; K = 8192; src = p.in[I_W2] + (size_t)l * DFF * DM; dst = (bf16_t*)(p.ws + OFF_W2); }
        else if ((x -= nt3) < nt4) { mode = 3; K = 512; src = p.in[I_GLUW] + (size_t)l * 512 * 1024; dst = (bf16_t*)(p.ws + OFF_WGLU); }
        else { x -= nt4; mode = 4; K = 512; src = p.in[I_POOLW] + (size_t)l * 4 * 128 * 128; dst = (bf16_t*)(p.ws + OFF_WPOOL); }
        const int ktiles = K / 256; k0 = (x % ktiles) * 256; n0 = (x / ktiles) * 64;
    };
    f32x4 v[8];
    int tI = blockIdx.x;
    if (tI < total) { int mode, K, k0, n0; const float* src; bf16_t* dst; decode(tI, mode, K, src, dst, k0, n0);
#pragma unroll
        for (int i = 0; i < 8; ++i) { const int e = tid + 512 * i, kk = e >> 4, n4 = (e & 15) * 4; v[i] = wload4(mode, src, k0 + kk, n0 + n4); } }
    for (; tI < total; tI += gridDim.x) {
        int mode, K, k0, n0; const float* src; bf16_t* dst; decode(tI, mode, K, src, dst, k0, n0);
#pragma unroll
        for (int i = 0; i < 8; ++i) { const int e = tid + 512 * i, kk = e >> 4, n4 = (e & 15) * 4;
#pragma unroll
            for (int j = 0; j < 4; ++j) tile[kk * 65 + ((n4 + j + (kk >> 3)) & 63)] = v[i][j]; }
        __syncthreads();
        if (tI + (int)gridDim.x < total) { int mode2, K2, k02, n02; const float* src2; bf16_t* dst2; decode(tI + gridDim.x, mode2, K2, src2, dst2, k02, n02);
#pragma unroll
            for (int i = 0; i < 8; ++i) { const int e = tid + 512 * i, kk = e >> 4, n4 = (e & 15) * 4; v[i] = wload4(mode2, src2, k02 + kk, n02 + n4); } }
#pragma unroll
        for (int i = 0; i < 4; ++i) { const int item = tid + 512 * i, kg = item & 31, nn = item >> 5; float w8[8];
#pragma unroll
            for (int jj = 0; jj < 8; ++jj) w8[jj] = tile[(kg * 8 + jj) * 65 + ((nn + kg) & 63)];
            u32x4 w; w.x = pk2(w8[0], w8[1]); w.y = pk2(w8[2], w8[3]); w.z = pk2(w8[4], w8[5]); w.w = pk2(w8[6], w8[7]);
            *(u32x4*)(dst + (size_t)(n0 + nn) * K + k0 + kg * 8) = w; }
        __syncthreads();
    }
}

__device__ __forceinline__ void store_norm_bf16(bf16_t* dstrow, const f32x4 (&v)[8], float rstd, const float* g, int lane) {
#pragma unroll
    for (int i = 0; i < 8; ++i) { const int c = 256 * i + 4 * lane; const f32x4 gg = *(const f32x4*)(g + c);
        uint2 w; w.x = pk2(v[i][0] * rstd * gg[0], v[i][1] * rstd * gg[1]); w.y = pk2(v[i][2] * rstd * gg[2], v[i][3] * rstd * gg[3]);
        *(uint2*)(dstrow + c) = w; }
}
__device__ __forceinline__ float sumsq(const f32x4 (&v)[8]) {
    float s = 0.f;
#pragma unroll
    for (int i = 0; i < 8; ++i) s += v[i][0] * v[i][0] + v[i][1] * v[i][1] + v[i][2] * v[i][2] + v[i][3] * v[i][3];
    return wsum(s);
}
__device__ __forceinline__ const float* in_row(const P& p, int r) { return r < NMAIN ? p.in[I_X] + (size_t)r * DM : p.in[I_META] + (size_t)((r - NMAIN) & 15) * DM; }
__device__ __forceinline__ void ld8x2(uint2 (&d)[8], const bf16_t* row, int lane) {
#pragma unroll
    for (int i = 0; i < 8; ++i) d[i] = *(const uint2*)(row + 256 * i + 4 * lane);
}
__device__ __forceinline__ void ld8x4(f32x4 (&d)[8], const float* row, int lane) {
#pragma unroll
    for (int i = 0; i < 8; ++i) d[i] = __builtin_nontemporal_load((const f32x4*)(row + 256 * i + 4 * lane));
}
__device__ __forceinline__ f32x4 cvt4(uint2 w) { return (f32x4){__uint_as_float(w.x << 16), __uint_as_float(w.x & 0xffff0000u), __uint_as_float(w.y << 16), __uint_as_float(w.y & 0xffff0000u)}; }
__device__ void row_first(const P& p) {
    const int lane = lt_tid() & 63, gw = blockIdx.x * 8 + (lt_tid() >> 6), nw = gridDim.x * 8;
    bf16_t* abuf = (bf16_t*)(p.ws + OFF_ABUF);
    f32x4 q[8];
    if (gw < MR) ld8x4(q, in_row(p, gw), lane);
    for (int r = gw; r < MR; r += nw) {
        f32x4 v[8];
#pragma unroll
        for (int i = 0; i < 8; ++i) v[i] = q[i];
        if (r + nw < MR) ld8x4(q, in_row(p, r + nw), lane);
        const float rstd = rsqrtf(sumsq(v) * (1.f / DM) + EPS);
        store_norm_bf16(abuf + (size_t)r * DM, v, rstd, p.in[I_GPREMIX], lane);
    }
}
template <bool FIRST>
__device__ void row_postmix_t(const P& p, int l) {
    const int lane = lt_tid() & 63, gw = blockIdx.x * 8 + (lt_tid() >> 6), nw = gridDim.x * 8;
    bf16_t* abuf = (bf16_t*)(p.ws + OFF_ABUF); const bf16_t* mix = (const bf16_t*)(p.ws + OFF_FBUF);
    const float* gpm = p.in[I_GPOSTMIX] + l * DM; const float* gpf = p.in[I_GPREFFN] + l * DM;
    const int rend = (l == DEPTH - 1) ? NMAIN : MR;
    uint2 vq[8]; f32x4 hf[8]; uint2 hq[8];
    if (gw < rend) { ld8x2(vq, mix + (size_t)gw * DM, lane); if (FIRST) ld8x4(hf, in_row(p, gw), lane); else ld8x2(hq, hrow(p, gw), lane); }
    for (int r = gw; r < rend; r += nw) {
        f32x4 v[8], hc[8];
#pragma unroll
        for (int i = 0; i < 8; ++i) { v[i] = cvt4(vq[i]); hc[i] = FIRST ? hf[i] : cvt4(hq[i]); }
        const int rn = r + nw;
        if (rn < rend) { ld8x2(vq, mix + (size_t)rn * DM, lane); if (FIRST) ld8x4(hf, in_row(p, rn), lane); else ld8x2(hq, hrow(p, rn), lane); }
        bf16_t* hd = hrow(p, r);
        const float rm = rsqrtf(sumsq(v) * (1.f / DM) + EPS);
#pragma unroll
        for (int i = 0; i < 8; ++i) { const f32x4 gg = *(const f32x4*)(gpm + 256 * i + 4 * lane); hc[i] = hc[i] + v[i] * rm * gg; st4bf(hd + 256 * i + 4 * lane, hc[i]); }
        const float rh = rsqrtf(sumsq(hc) * (1.f / DM) + EPS);
        store_norm_bf16(abuf + (size_t)r * DM, hc, rh, gpf, lane);
    }
}
__device__ void row_postmix(const P& p, int l) { if (l == 0) row_postmix_t<true>(p, l); else row_postmix_t<false>(p, l); }
template <bool LAST>
__device__ void row_postffn_t(const P& p, int l) {
    const int lane = lt_tid() & 63, gw = blockIdx.x * 8 + (lt_tid() >> 6), nw = gridDim.x * 8;
    bf16_t* abuf = (bf16_t*)(p.ws + OFF_ABUF);
    const float* gpf = p.in[I_GPOSTFFN] + l * DM;
    const int rend = LAST ? NMAIN : MR;
    uint2 vq[8], hq[8];
    if (gw < rend) { ld8x2(vq, abuf + (size_t)gw * DM, lane); ld8x2(hq, hrow(p, gw), lane); }
    for (int r = gw; r < rend; r += nw) {
        f32x4 v[8], hc[8];
#pragma unroll
        for (int i = 0; i < 8; ++i) { v[i] = cvt4(vq[i]); hc[i] = cvt4(hq[i]); }
        const int rn = r + nw;
        if (rn < rend) { ld8x2(vq, abuf + (size_t)rn * DM, lane); ld8x2(hq, hrow(p, rn), lane); }
        bf16_t* hd = hrow(p, r);
        const float rm = rsqrtf(sumsq(v) * (1.f / DM) + EPS);
#pragma unroll
        for (int i = 0; i < 8; ++i) { const f32x4 gg = *(const f32x4*)(gpf + 256 * i + 4 * lane); hc[i] = hc[i] + v[i] * rm * gg;
            if (LAST) __builtin_nontemporal_store(hc[i], (f32x4*)(p.out + (size_t)r * DM + 256 * i + 4 * lane)); else st4bf(hd + 256 * i + 4 * lane, hc[i]); }
        if (!LAST) { const float rh = rsqrtf(sumsq(hc) * (1.f / DM) + EPS); store_norm_bf16(abuf + (size_t)r * DM, hc, rh, p.in[I_GPREMIX] + (l + 1) * DM, lane); }
    }
}
__device__ void row_postffn(const P& p, int l) { if (l == DEPTH - 1) row_postffn_t<true>(p, l); else row_postffn_t<false>(p, l); }

typedef float f32x2 __attribute__((ext_vector_type(2)));
struct S5Par { float ar, ai; f32x2 bb[16]; };
__device__ __forceinline__ void s5_params(const P& p, int l, int g, int pp, S5Par& q) {
    const int gi = l * 32 + g; const float lre = p.in[I_LRE][gi * 64 + pp], lim = p.in[I_LIM][gi * 64 + pp], dt = expf(p.in[I_LOGDT][gi]);
    const float er = expf(lre * dt); float sn, cs; sincosf(lim * dt, &sn, &cs); q.ar = er * cs; q.ai = er * sn;
    const float nr = q.ar - 1.f, ni = q.ai, den = 1.f / (lre * lre + lim * lim);
    const float cr = (nr * lre + ni * lim) * den, ci = (ni * lre - nr * lim) * den;
    const float* br = p.in[I_BRE] + ((size_t)gi * 64 + pp) * 16; const float* bi = p.in[I_BIM] + ((size_t)gi * 64 + pp) * 16;
#pragma unroll
    for (int h = 0; h < 16; ++h) { const float x = br[h], y = bi[h]; q.bb[h] = (f32x2){cr * x - ci * y, cr * y + ci * x}; }
}
__device__ __forceinline__ void s5_step(const S5Par& q, const float* ul, float& sr, float& si) {
    const f32x4 u0 = *(const f32x4*)ul, u1 = *(const f32x4*)(ul + 4), u2 = *(const f32x4*)(ul + 8), u3 = *(const f32x4*)(ul + 12);
    const float u[16] = {u0[0], u0[1], u0[2], u0[3], u1[0], u1[1], u1[2], u1[3], u2[0], u2[1], u2[2], u2[3], u3[0], u3[1], u3[2], u3[3]};
    f32x2 bu = {0.f, 0.f}, bv = {0.f, 0.f};
#pragma unroll
    for (int i = 0; i < 8; ++i) { bu = __builtin_elementwise_fma((f32x2){u[2 * i], u[2 * i]}, q.bb[2 * i], bu); bv = __builtin_elementwise_fma((f32x2){u[2 * i + 1], u[2 * i + 1]}, q.bb[2 * i + 1], bv); }
    bu = bu + bv;
    f32x2 t = __builtin_elementwise_fma((f32x2){q.ai, q.ai}, (f32x2){-si, sr}, bu);
    t = __builtin_elementwise_fma((f32x2){q.ar, q.ar}, (f32x2){sr, si}, t);
    sr = t.x; si = t.y;
}
__device__ __forceinline__ void s5_put(float* dst, const int (&ur)[8]) {
#pragma unroll
    for (int i = 0; i < 4; ++i) { const unsigned a = (unsigned)ur[2 * i], b = (unsigned)ur[2 * i + 1];
        *(f32x4*)(dst + 4 * i) = (f32x4){__uint_as_float(a << 16), __uint_as_float(a & 0xffff0000u), __uint_as_float(b << 16), __uint_as_float(b & 0xffff0000u)}; }
}
#define S5_LOADU(ur, up, tg, nt, lane) do { const int tt_ = min((tg) + (lane), (nt) - 1); const uint4 a_ = *(const uint4*)((up) + (size_t)tt_ * NPROJ), b_ = *(const uint4*)((up) + (size_t)tt_ * NPROJ + 8); \
        ur[0] = a_.x; ur[1] = a_.y; ur[2] = a_.z; ur[3] = a_.w; ur[4] = b_.x; ur[5] = b_.y; ur[6] = b_.z; ur[7] = b_.w; } while (0)
#define S5_BCAST(w, ur, tl) do { w[0] = __builtin_amdgcn_readlane(ur[0], tl); w[1] = __builtin_amdgcn_readlane(ur[1], tl); w[2] = __builtin_amdgcn_readlane(ur[2], tl); w[3] = __builtin_amdgcn_readlane(ur[3], tl); \
        w[4] = __builtin_amdgcn_readlane(ur[4], tl); w[5] = __builtin_amdgcn_readlane(ur[5], tl); w[6] = __builtin_amdgcn_readlane(ur[6], tl); w[7] = __builtin_amdgcn_readlane(ur[7], tl); } while (0)
__device__ void s5_pass1(const P& p, int l, int jb, unsigned char* smem) {
    const int tid = lt_tid(), wid = __builtin_amdgcn_readfirstlane(tid >> 6), lane = tid & 63;
    const int b = jb / 132, rem = jb % 132, c = rem >> 2, g = (rem & 3) * 8 + wid;
    float* Uf = (float*)smem + wid * (64 * 16);
    S5Par q; s5_params(p, l, g, lane, q);
    const int t0 = c == 0 ? 0 : 128 * c - 112, nt = c == 0 ? 16 : 128;
    const bf16_t* up = (const bf16_t*)(p.ws + OFF_PROJ) + (size_t)rmap(b, t0) * NPROJ + C_S5U + g * 16;
    float sr = 0.f, si = 0.f;
    int ur[8], un[8];
    S5_LOADU(ur, up, 0, nt, lane);
    for (int tg = 0; tg < nt; tg += 64) {
        s5_put(Uf + lane * 16, ur);
        if (tg + 64 < nt) S5_LOADU(un, up, tg + 64, nt, lane);
        __builtin_amdgcn_wave_barrier();
        const int cnt = min(64, nt - tg);
#pragma unroll 4
        for (int tl = 0; tl < cnt; ++tl) s5_step(q, Uf + tl * 16, sr, si);
        __builtin_amdgcn_wave_barrier();
#pragma unroll
        for (int k = 0; k < 8; ++k) ur[k] = un[k];
    }
    ((float2*)(p.ws + OFF_S5E))[(size_t)(b * NCH + c) * 2048 + g * 64 + lane] = make_float2(sr, si);
}
__device__ void s5_carry(const P& p, int l, int jb) {
    const int id = jb * 512 + lt_tid(), b = id >> 11, gp = id & 2047, gi = l * 32 + (gp >> 6);
    const float lre = p.in[I_LRE][gi * 64 + (gp & 63)], lim = p.in[I_LIM][gi * 64 + (gp & 63)], dt = expf(p.in[I_LOGDT][gi]);
    const float er = expf(128.f * lre * dt); float sn, cs; sincosf(128.f * lim * dt, &sn, &cs); const float ar = er * cs, ai = er * sn;
    const float2* E = (const float2*)(p.ws + OFF_S5E); float2* SI = (float2*)(p.ws + OFF_S5IN);
    float sr = 0.f; asm volatile("" : "+v"(sr)); float si = sr;
    for (int c0 = 0; c0 < NCH; c0 += 11) { float2 eb[11];
#pragma unroll
        for (int i = 0; i < 11; ++i) eb[i] = E[(size_t)(b * NCH + c0 + i) * 2048 + gp];
#pragma unroll
        for (int i = 0; i < 11; ++i) { SI[(size_t)(b * NCH + c0 + i) * 2048 + gp] = make_float2(sr, si);
            const float nsr = ar * sr - ai * si + eb[i].x, nsi = ar * si + ai * sr + eb[i].y; sr = nsr; si = nsi; } }
}
__device__ __forceinline__ float gelu_tanh(float y) { const float z = 0.7978845608028654f * (y + 0.044715f * y * y * y); const float th = 1.f - 2.f / (__expf(2.f * z) + 1.f); return 0.5f * y * (1.f + th); }
__device__ void s5_pass2(const P& p, int l, int jb, unsigned char* smem) {
    const int wid = __builtin_amdgcn_readfirstlane(lt_tid() >> 6), lane = lt_tid() & 63, ln = lane & 15, g4 = lane >> 4;
    const int b = jb / 132, rem = jb % 132, c = rem >> 2, g = (rem & 3) * 8 + wid, gi = l * 32 + g;
    unsigned char* wbase = smem + wid * (4352 + 4096 + 4096);
    bf16_t* Xs = (bf16_t*)wbase; float* Uf = (float*)(wbase + 4352); bf16_t* Ys = (bf16_t*)(wbase + 4352 + 4096);
    S5Par q; s5_params(p, l, g, lane, q);
    bf16x8 cf[4];
#pragma unroll
    for (int ks = 0; ks < 4; ++ks) { const int pp = 16 * ks + 4 * g4;
        const f32x4 cr = *(const f32x4*)(p.in[I_CRE] + ((size_t)gi * 16 + ln) * 64 + pp), ci = *(const f32x4*)(p.in[I_CIM] + ((size_t)gi * 16 + ln) * 64 + pp);
        u32x4 w; w.x = pk2(cr[0], -ci[0]); w.y = pk2(cr[1], -ci[1]); w.z = pk2(cr[2], -ci[2]); w.w = pk2(cr[3], -ci[3]); cf[ks] = *(bf16x8*)&w; }
    const float dv = p.in[I_SD][gi * 16 + ln];
    const int t0 = c == 0 ? 0 : 128 * c - 112, nt = c == 0 ? 16 : 128;
    const bf16_t* up = (const bf16_t*)(p.ws + OFF_PROJ) + (size_t)rmap(b, t0) * NPROJ + C_S5U + g * 16;
    bf16_t* sy = (bf16_t*)(p.ws + OFF_SY) + (size_t)rmap(b, t0) * 512 + g * 16;
    const float2 s0 = ((const float2*)(p.ws + OFF_S5IN))[(size_t)(b * NCH + c) * 2048 + g * 64 + lane];
    float sr = s0.x, si = s0.y;
    int ur[8], un[8];
    S5_LOADU(ur, up, 0, nt, lane);
    for (int tg0 = 0; tg0 < nt; tg0 += 64) {
        s5_put(Uf + lane * 16, ur);
        if (tg0 + 64 < nt) S5_LOADU(un, up, tg0 + 64, nt, lane);
        __builtin_amdgcn_wave_barrier();
        const int cnt = min(64, nt - tg0);
        for (int sub = 0; sub < cnt; sub += 16) {
            const int tg = tg0 + sub;
#pragma unroll 4
            for (int tl = 0; tl < 16; ++tl) { s5_step(q, Uf + (sub + tl) * 16, sr, si); *(unsigned*)(Xs + tl * 136 + 2 * lane) = pk2(sr, si); }
            __builtin_amdgcn_wave_barrier();
            f32x4 acc = {0.f, 0.f, 0.f, 0.f};
#pragma unroll
            for (int ks = 0; ks < 4; ++ks) { const bf16x8 a = *(const bf16x8*)(Xs + ln * 136 + 32 * ks + 8 * g4); acc = MFMA16(a, cf[ks], acc); }
#pragma unroll
            for (int j = 0; j < 4; ++j) { const float u = Uf[(sub + 4 * g4 + j) * 16 + ln];
                const float y = gelu_tanh(acc[j] + dv * u); Ys[(tg + 4 * g4 + j) * 16 + ln] = (bf16_t)(pk2(y, 0.f) & 0xffffu); }
            __builtin_amdgcn_wave_barrier();
        }
#pragma unroll
        for (int k = 0; k < 8; ++k) ur[k] = un[k];
    }
    __builtin_amdgcn_wave_barrier();
#pragma unroll
    for (int hh = 0; hh < 2; ++hh) { const int tk = lane + 64 * hh;
        if (tk < nt) { const uint4 y0 = *(const uint4*)(Ys + tk * 16), y1 = *(const uint4*)(Ys + tk * 16 + 8); *(uint4*)(sy + (size_t)tk * 512) = y0; *(uint4*)(sy + (size_t)tk * 512 + 8) = y1; } }
    __builtin_amdgcn_wave_barrier();
}

__device__ void pool_pre(const P& p, int jb) {
    const bf16_t* proj = (const bf16_t*)(p.ws + OFF_PROJ); bf16_t* pooled = (bf16_t*)(p.ws + OFF_POOLED);
    const int tid = lt_tid(), cg8 = tid & 63, c = cg8 * 8, w = 2 << (c >> 7);
    const int r0 = jb * 32 + (tid >> 6) * 4; if (r0 >= MR) return;
    const int b = r0 < NMAIN ? (r0 >> 12) : ((r0 - NMAIN) >> 4), t0 = r0 < NMAIN ? (r0 & 4095) + 16 : ((r0 - NMAIN) & 15);
    uint4 xs[19];
#pragma unroll
    for (int i = 0; i < 19; ++i) { const int tt = t0 - 15 + i; xs[i] = make_uint4(0, 0, 0, 0); if (tt >= 0 && i >= 16 - w) xs[i] = *(const uint4*)(proj + (size_t)rmap(b, tt) * NPROJ + C_PLU + c); }
    float sacc[4][8], self[4][8];
#pragma unroll
    for (int q = 0; q < 4; ++q)
#pragma unroll
        for (int k = 0; k < 8; ++k) { sacc[q][k] = 0.f; self[q][k] = 0.f; }
#pragma unroll
    for (int i = 0; i < 19; ++i) { const unsigned xw[4] = {xs[i].x, xs[i].y, xs[i].z, xs[i].w}; float f[8];
#pragma unroll
        for (int k = 0; k < 4; ++k) { f[2 * k] = __uint_as_float(xw[k] << 16); f[2 * k + 1] = __uint_as_float(xw[k] & 0xffff0000u); }
#pragma unroll
        for (int q = 0; q < 4; ++q) {
            if (i <= 15 + q) { const bool in = i >= 16 + q - w;
#pragma unroll
                for (int k = 0; k < 8; ++k) sacc[q][k] += in ? f[k] : 0.f; }
            if (i == 15 + q) {
#pragma unroll
                for (int k = 0; k < 8; ++k) self[q][k] = f[k]; } } }
#pragma unroll
    for (int q = 0; q < 4; ++q) { const int t = t0 + q, cnt = min(t + 1, w); const float inv = 1.f / (float)cnt;
        u32x4 o; o.x = pk2(sacc[q][0] * inv - self[q][0], sacc[q][1] * inv - self[q][1]); o.y = pk2(sacc[q][2] * inv - self[q][2], sacc[q][3] * inv - self[q][3]);
        o.z = pk2(sacc[q][4] * inv - self[q][4], sacc[q][5] * inv - self[q][5]); o.w = pk2(sacc[q][6] * inv - self[q][6], sacc[q][7] * inv - self[q][7]);
        *(u32x4*)(pooled + (size_t)(r0 + q) * 512 + c) = o; }
}
__device__ void fox_cum(const P& p, int l, int bh, unsigned char* smem) {
    float* sw = (float*)smem;
    const int tid = lt_tid(), lane = tid & 63, wid = tid >> 6, b = bh >> 2, h = bh & 3; const float bias = p.in[I_FXGB][l * 4 + h];
    const float* gates = (const float*)(p.ws + OFF_GATES); float* cum = (float*)(p.ws + OFF_CUM) + bh * LPF;
    if (tid < 112) cum[tid] = 0.f;
    const int ta = tid * 9; float v[9], s = 0.f;
#pragma unroll
    for (int i = 0; i < 9; ++i) { const int t = ta + i; v[i] = t < LT ? gates[(size_t)rmap(b, t) * 16 + 8 + h] : 0.f; }
#pragma unroll
    for (int i = 0; i < 9; ++i) { const int t = ta + i; s += t < LT ? logsig(v[i] + bias) : 0.f; v[i] = s; }
    float inc = s;
    for (int o = 1; o < 64; o <<= 1) { const float n = __shfl_up(inc, o); if (lane >= o) inc += n; }
    if (lane == 63) sw[wid] = inc;
    __syncthreads();
    float base = inc - s;
    for (int w = 0; w < wid; ++w) base += sw[w];
#pragma unroll
    for (int i = 0; i < 9; ++i) { const int t = ta + i; if (t < LT) cum[112 + t] = base + v[i]; }
    __syncthreads();
}

__device__ void ml_pass1(const P& p, int l, int j, unsigned char* smem) {
    const int tid = lt_tid(), wid = __builtin_amdgcn_readfirstlane(tid >> 6), lane = tid & 63, ln = lane & 15, g = lane >> 4, q4 = (lane >> 2) & 3, p4 = lane & 3;
    const int bh = j / NCH, c = j % NCH, b = bh >> 2, h = bh & 3, t0 = 128 * c - 112;
    bf16_t* Vs = (bf16_t*)smem;
    bf16_t* Kw = Vs + 128 * 144;
    float* fw = (float*)(Kw + 128 * 144);
    float* fx = fw + 128;
    float* fpart = fx + 8;
    const bf16_t* proj = (const bf16_t*)(p.ws + OFF_PROJ); const float* gates = (const float*)(p.ws + OFF_GATES);
    float lf = 0.f, li = NEGB, bs = 0.f;
    if (tid < 128) { const int t = t0 + tid;
        if (t >= 0) { const float* gp = gates + (size_t)rmap(b, t) * 16; li = gp[h] + p.in[I_MLGB][l * 8 + h]; lf = logsig(gp[4 + h] + p.in[I_MLGB][l * 8 + 4 + h]); }
        bs = lf;
        for (int o = 1; o < 64; o <<= 1) { const float n = __shfl_up(bs, o); if (lane >= o) bs += n; }
        if (tid == 63) fx[0] = bs; }
    __syncthreads();
    if (tid >= 64 && tid < 128) bs += fx[0];
    if (tid == 127) fx[1] = bs;
    __syncthreads();
    const float gtot = fx[1];
    float as = NEGB;
    if (tid < 128) { as = gtot - bs + li; const float mw = wmaxf(as); if (lane == 0) fx[2 + wid] = mw; }
    __syncthreads();
    const float mloc = fmaxf(fx[2], fx[3]);
    if (tid < 128) { fw[tid] = expf(as - mloc);
        ((float*)(p.ws + OFF_BCUM))[bh * LPF + 128 * c + tid] = bs; ((float*)(p.ws + OFF_MLI))[bh * LPF + 128 * c + tid] = li;
        if (tid == 0) { ((float*)(p.ws + OFF_MLG))[j] = gtot; ((float*)(p.ws + OFF_MLM))[j] = mloc; } }
    __syncthreads();
    const float* cw = p.in[I_CONVW] + (size_t)l * 4 * 1024;
    bf16_t* qc = (bf16_t*)(p.ws + OFF_QC); bf16_t* kc = (bf16_t*)(p.ws + OFF_KC);
#pragma unroll 4
    for (int it = 0; it < 8; ++it) {
        const int id = tid + 512 * (it & 3), s = id >> 4, dg = id & 15, isk = it >> 2, t = t0 + s;
        const int ch = h * 128 + dg * 8;
        float a[8] = {0, 0, 0, 0, 0, 0, 0, 0};
        if (t >= 0) {
            uint4 xt[4];
#pragma unroll
            for (int jj = 0; jj < 4; ++jj) { const int tt = t - 3 + jj; xt[jj] = make_uint4(0, 0, 0, 0); if (tt >= 0) xt[jj] = *(const uint4*)(proj + (size_t)rmap(b, tt) * NPROJ + (isk ? C_MLK : C_MLQ) + ch); }
#pragma unroll
            for (int jj = 0; jj < 4; ++jj) { const unsigned xw[4] = {xt[jj].x, xt[jj].y, xt[jj].z, xt[jj].w};
                const float* wp = cw + jj * 1024 + isk * 512 + ch; const f32x4 w0 = *(const f32x4*)wp, w1 = *(const f32x4*)(wp + 4);
                const float wv[8] = {w0[0], w0[1], w0[2], w0[3], w1[0], w1[1], w1[2], w1[3]};
#pragma unroll
                for (int i = 0; i < 4; ++i) { a[2 * i] = fmaf(__uint_as_float(xw[i] << 16), wv[2 * i], a[2 * i]); a[2 * i + 1] = fmaf(__uint_as_float(xw[i] & 0xffff0000u), wv[2 * i + 1], a[2 * i + 1]); } }
#pragma unroll
            for (int i = 0; i < 8; ++i) a[i] = a[i] / (1.f + __expf(-a[i]));
        }
        if (!isk) { if (t >= 0) { u32x4 o; o.x = pk2(a[0], a[1]); o.y = pk2(a[2], a[3]); o.z = pk2(a[4], a[5]); o.w = pk2(a[6], a[7]); *(u32x4*)(qc + (size_t)rmap(b, t) * 512 + ch) = o; } }
        else {
#pragma unroll
            for (int i = 0; i < 8; ++i) a[i] *= 0.08838834764831845f;
            if (t >= 0) { u32x4 o; o.x = pk2(a[0], a[1]); o.y = pk2(a[2], a[3]); o.z = pk2(a[4], a[5]); o.w = pk2(a[6], a[7]); *(u32x4*)(kc + (size_t)rmap(b, t) * 512 + ch) = o; }
            const float ws = t >= 0 ? fw[s] : 0.f;
            u32x4 o; o.x = pk2(a[0] * ws, a[1] * ws); o.y = pk2(a[2] * ws, a[3] * ws); o.z = pk2(a[4] * ws, a[5] * ws); o.w = pk2(a[6] * ws, a[7] * ws);
            *(u32x4*)(Kw + s * 144 + dg * 8) = o;
            uint4 vv = make_uint4(0, 0, 0, 0); if (t >= 0) vv = *(const uint4*)(proj + (size_t)rmap(b, t) * NPROJ + C_MLV + ch);
            *(uint4*)(Vs + s * 144 + dg * 8) = vv;
        }
    }
    __syncthreads();
    f32x4 acc[8];
#pragma unroll
    for (int nt = 0; nt < 8; ++nt) acc[nt] = (f32x4){0.f, 0.f, 0.f, 0.f};
#pragma unroll
    for (int ks = 0; ks < 4; ++ks) {
        const int r0 = 32 * ks + 8 * g + q4;
        const bf16x8 af = cat8(trrd(Vs + r0 * 144 + 16 * wid + 4 * p4), trrd(Vs + (r0 + 4) * 144 + 16 * wid + 4 * p4));
#pragma unroll
        for (int nt = 0; nt < 8; ++nt) { const bf16x8 bfr = cat8(trrd(Kw + r0 * 144 + 16 * nt + 4 * p4), trrd(Kw + (r0 + 4) * 144 + 16 * nt + 4 * p4)); acc[nt] = MFMA16(af, bfr, acc[nt]); }
    }
    float* cl = (float*)(p.ws + OFF_CLOC) + (size_t)j * 16384;
#pragma unroll
    for (int nt = 0; nt < 8; ++nt)
#pragma unroll
        for (int jj = 0; jj < 4; ++jj) cl[(16 * wid + 4 * g + jj) * 128 + 16 * nt + ln] = acc[nt][jj];
    { const int kk = tid & 127, part = tid >> 7; float s = 0.f;
#pragma unroll 8
      for (int ss = 0; ss < 32; ++ss) s += bf2f(Kw[(part * 32 + ss) * 144 + kk]);
      fpart[part * 128 + kk] = s; }
    __syncthreads();
    if (tid < 128) ((float*)(p.ws + OFF_NLOC))[j * 128 + tid] = fpart[tid] + fpart[128 + tid] + fpart[256 + tid] + fpart[384 + tid];
    __syncthreads();
}
__device__ void ml_scan(const P& p, int jb) {
    const int bh = jb >> 3, part = jb & 7, tid = lt_tid();
    float* cl = (float*)(p.ws + OFF_CLOC); float* nl = (float*)(p.ws + OFF_NLOC);
    const float* G = (const float*)(p.ws + OFF_MLG); const float* ML = (const float*)(p.ws + OFF_MLM); float* MS = (float*)(p.ws + OFF_MST);
    f32x4 C = {0.f, 0.f, 0.f, 0.f}; float n = 0.f, m = 0.f;
    const bool don = (part == 0 && tid < 128);
    for (int c0 = 0; c0 < NCH; c0 += 11) {
        f32x4 xb[11]; float gb[11], mlb[11], nxb[11];
#pragma unroll
        for (int i = 0; i < 11; ++i) { const int j = bh * NCH + c0 + i;
            xb[i] = *(const f32x4*)(cl + (size_t)j * 16384 + part * 2048 + tid * 4); gb[i] = G[j]; mlb[i] = ML[j]; nxb[i] = don ? nl[j * 128 + tid] : 0.f; }
#pragma unroll
        for (int i = 0; i < 11; ++i) { const int j = bh * NCH + c0 + i;
            *(f32x4*)(cl + (size_t)j * 16384 + part * 2048 + tid * 4) = C;
            if (don) nl[j * 128 + tid] = n;
            if (part == 0 && tid == 0) MS[j] = m;
            const float mn = fmaxf(gb[i] + m, mlb[i]), dec = expf(gb[i] + m - mn), sc = expf(mlb[i] - mn);
            C = C * dec + xb[i] * sc; n = n * dec + nxb[i] * sc; m = mn; }
    }
}
__device__ void ml_pass2(const P& p, int l, int j, unsigned char* smem) {
    const int tid = lt_tid(), wid = __builtin_amdgcn_readfirstlane(tid >> 6), lane = tid & 63, ln = lane & 15, g = lane >> 4, q4 = (lane >> 2) & 3, p4 = lane & 3;
    const int bh = j / NCH, c = j % NCH, b = bh >> 2, h = bh & 3, t0 = 128 * c - 112;
    bf16_t* Ks = (bf16_t*)smem;
    bf16_t* Cs = Ks + 128 * 136;
    bf16_t* Vs = Cs + 128 * 136;
    float* fb = (float*)(Vs + 128 * 144); float* fli = fb + 128; float* fn = fli + 128;
    const bf16_t* proj = (const bf16_t*)(p.ws + OFF_PROJ);
    const bf16_t* qc = (const bf16_t*)(p.ws + OFF_QC); const bf16_t* kc = (const bf16_t*)(p.ws + OFF_KC);
    const float* cst = (const float*)(p.ws + OFF_CLOC) + (size_t)j * 16384;
#pragma unroll
    for (int it = 0; it < 4; ++it) { const int id = tid + 512 * it, s = id >> 4, dg = id & 15, t = t0 + s;
        uint4 kk = make_uint4(0, 0, 0, 0), vv = kk;
        if (t >= 0) { kk = *(const uint4*)(kc + (size_t)rmap(b, t) * 512 + h * 128 + dg * 8); vv = *(const uint4*)(proj + (size_t)rmap(b, t) * NPROJ + C_MLV + h * 128 + dg * 8); }
        *(uint4*)(Ks + s * 136 + dg * 8) = kk; *(uint4*)(Vs + s * 144 + dg * 8) = vv;
        const f32x4 c0 = *(const f32x4*)(cst + s * 128 + dg * 8), c1 = *(const f32x4*)(cst + s * 128 + dg * 8 + 4);
        u32x4 o; o.x = pk2(c0[0], c0[1]); o.y = pk2(c0[2], c0[3]); o.z = pk2(c1[0], c1[1]); o.w = pk2(c1[2], c1[3]); *(u32x4*)(Cs + s * 136 + dg * 8) = o; }
    if (tid < 128) { fb[tid] = ((const float*)(p.ws + OFF_BCUM))[bh * LPF + 128 * c + tid]; fli[tid] = ((const float*)(p.ws + OFF_MLI))[bh * LPF + 128 * c + tid]; fn[tid] = ((const float*)(p.ws + OFF_NLOC))[j * 128 + tid]; }
    const float mst = ((const float*)(p.ws + OFF_MST))[j];
    __syncthreads();
    const int tl = 16 * wid + ln, tq = t0 + tl;
    if (t0 + 16 * wid >= 0) {
        const size_t r = (size_t)rmap(b, tq);
        bf16x8 qf[4];
#pragma unroll
        for (int ks = 0; ks < 4; ++ks) qf[ks] = *(const bf16x8*)(qc + r * 512 + h * 128 + 32 * ks + 8 * g);
        const float bt = fb[tl];
        f32x4 sc[8]; float mx = NEGB;
#pragma unroll
        for (int mt = 0; mt < 8; ++mt) { sc[mt] = (f32x4){0.f, 0.f, 0.f, 0.f};
            if (mt <= wid) {
#pragma unroll
                for (int ks = 0; ks < 4; ++ks) { const bf16x8 a = *(const bf16x8*)(Ks + (16 * mt + ln) * 136 + 32 * ks + 8 * g); sc[mt] = MFMA16(a, qf[ks], sc[mt]); }
            } }
#pragma unroll
        for (int mt = 0; mt < 8; ++mt) {
            if (mt <= wid) { const f32x4 bsv = *(const f32x4*)(fb + 16 * mt + 4 * g), liv = *(const f32x4*)(fli + 16 * mt + 4 * g);
#pragma unroll
                for (int jj = 0; jj < 4; ++jj) { const int s = 16 * mt + 4 * g + jj; const float d = (s <= tl) ? (bt - bsv[jj] + liv[jj]) : NEGB; mx = fmaxf(mx, d); } } }
        mx = fmaxf(mx, __shfl_xor(mx, 16)); mx = fmaxf(mx, __shfl_xor(mx, 32));
        const float minter = bt + mst, mcomb = fmaxf(minter, mx), iw = __builtin_amdgcn_exp2f((minter - mcomb) * LOG2E);
        float dsum = 0.f;
#pragma unroll
        for (int mt = 0; mt < 8; ++mt) {
            if (mt <= wid) { const f32x4 bsv = *(const f32x4*)(fb + 16 * mt + 4 * g), liv = *(const f32x4*)(fli + 16 * mt + 4 * g);
#pragma unroll
                for (int jj = 0; jj < 4; ++jj) { const int s = 16 * mt + 4 * g + jj; const float d = (s <= tl) ? (bt - bsv[jj] + liv[jj]) : NEGB;
                    const float w = sc[mt][jj] * __builtin_amdgcn_exp2f((d - mcomb) * LOG2E); sc[mt][jj] = w; dsum += w; } } }
        f32x4 acc[8];
#pragma unroll
        for (int vt = 0; vt < 8; ++vt) { acc[vt] = (f32x4){0.f, 0.f, 0.f, 0.f};
#pragma unroll
            for (int ks = 0; ks < 4; ++ks) { const bf16x8 a = *(const bf16x8*)(Cs + (16 * vt + ln) * 136 + 32 * ks + 8 * g); acc[vt] = MFMA16(a, qf[ks], acc[vt]); }
            acc[vt] = acc[vt] * iw; }
        float qn = 0.f;
#pragma unroll
        for (int ks = 0; ks < 4; ++ks)
#pragma unroll
            for (int i = 0; i < 8; ++i) qn = fmaf(bf2f((unsigned short)qf[ks][i]), fn[32 * ks + 8 * g + i], qn);
#pragma unroll
        for (int a = 0; a < 4; ++a) {
            if (2 * a <= wid) {
                u32x4 w; w.x = pk2(sc[2 * a][0], sc[2 * a][1]); w.y = pk2(sc[2 * a][2], sc[2 * a][3]); w.z = pk2(sc[2 * a + 1][0], sc[2 * a + 1][1]); w.w = pk2(sc[2 * a + 1][2], sc[2 * a + 1][3]);
                const bf16x8 pb = *(bf16x8*)&w;
                const int r0 = 32 * a + 4 * g + q4;
#pragma unroll
                for (int vt = 0; vt < 8; ++vt) { const bf16x8 af = cat8(trrd(Vs + r0 * 144 + 16 * vt + 4 * p4), trrd(Vs + (r0 + 16) * 144 + 16 * vt + 4 * p4)); acc[vt] = MFMA16(af, pb, acc[vt]); }
            } }
        dsum += __shfl_xor(dsum, 16); dsum += __shfl_xor(dsum, 32); qn += __shfl_xor(qn, 16); qn += __shfl_xor(qn, 32);
        const float den = dsum + iw * qn, dnm = 1.f / fmaxf(fabsf(den), expf(-mcomb));
        float ss = 0.f;
#pragma unroll
        for (int vt = 0; vt < 8; ++vt) { acc[vt] = acc[vt] * dnm; ss += acc[vt][0] * acc[vt][0] + acc[vt][1] * acc[vt][1] + acc[vt][2] * acc[vt][2] + acc[vt][3] * acc[vt][3]; }
        ss += __shfl_xor(ss, 16); ss += __shfl_xor(ss, 32);
        const float rs = rsqrtf(ss * (1.f / 128.f) + EPS);
        bf16_t* yo = (bf16_t*)(p.ws + OFF_ABUF) + r * DM + 512 + h * 128;
        const float* ng = p.in[I_NORMG] + l * 512 + h * 128;
#pragma unroll
        for (int vt = 0; vt < 8; ++vt) { const int v0 = 16 * vt + 4 * g; const f32x4 gg = *(const f32x4*)(ng + v0);
            const uint2 ow = *(const uint2*)(proj + r * NPROJ + C_MLO + h * 128 + v0);
            const float o0 = sigm(__uint_as_float(ow.x << 16)), o1 = sigm(__uint_as_float(ow.x & 0xffff0000u)), o2 = sigm(__uint_as_float(ow.y << 16)), o3 = sigm(__uint_as_float(ow.y & 0xffff0000u));
            uint2 w; w.x = pk2(acc[vt][0] * rs * gg[0] * o0, acc[vt][1] * rs * gg[1] * o1); w.y = pk2(acc[vt][2] * rs * gg[2] * o2, acc[vt][3] * rs * gg[3] * o3);
            *(uint2*)(yo + v0) = w; }
    }
    __syncthreads();
}

__device__ __forceinline__ void fox_softmax(f32x4 (&sc)[4], f32x4 (&acc)[8], float& m, float& ls, bf16x8 (&pb)[2], const float* ckb, float ct, int tq, int kbase_t, bool domask, int g) {
    constexpr float C2 = 0.08838834764831845f * LOG2E;
    float mx = -__builtin_inff();
    if (domask) {
#pragma unroll
        for (int mt = 0; mt < 4; ++mt) { const f32x4 cv = *(const f32x4*)(ckb + 16 * mt + 4 * g);
#pragma unroll
            for (int jj = 0; jj < 4; ++jj) { float v = fmaf(sc[mt][jj], C2, cv[jj]);
                const int kt_t = kbase_t + 16 * mt + 4 * g + jj; if (kt_t < 0 || kt_t > tq) v = -__builtin_inff();
                sc[mt][jj] = v; mx = fmaxf(mx, v); } }
    } else {
#pragma unroll
        for (int mt = 0; mt < 4; ++mt) { const f32x4 cv = *(const f32x4*)(ckb + 16 * mt + 4 * g);
#pragma unroll
            for (int jj = 0; jj < 4; ++jj) { const float v = fmaf(sc[mt][jj], C2, cv[jj]); sc[mt][jj] = v; mx = fmaxf(mx, v); } }
    }
    mx = fmaxf(mx, __shfl_xor(mx, 16)); mx = fmaxf(mx, __shfl_xor(mx, 32));
    const bool keep = __all(mx - m <= 8.f);
    float mn = m;
    if (!keep) { mn = fmaxf(m, mx); const float alpha = __builtin_amdgcn_exp2f(m - mn); m = mn; ls *= alpha;
#pragma unroll
        for (int vt = 0; vt < 8; ++vt) acc[vt] = acc[vt] * alpha; }
    float ps = 0.f;
#pragma unroll
    for (int mt = 0; mt < 4; ++mt)
#pragma unroll
        for (int jj = 0; jj < 4; ++jj) { const float e = __builtin_amdgcn_exp2f(sc[mt][jj] - mn); sc[mt][jj] = e; ps += e; }
    ls += ps;
#pragma unroll
    for (int a = 0; a < 2; ++a) { u32x4 w; w.x = pk2(sc[2 * a][0], sc[2 * a][1]); w.y = pk2(sc[2 * a][2], sc[2 * a][3]); w.z = pk2(sc[2 * a + 1][0], sc[2 * a + 1][1]); w.w = pk2(sc[2 * a + 1][2], sc[2 * a + 1][3]); pb[a] = *(bf16x8*)&w; }
}
template <bool BOTH>
__device__ __forceinline__ void fox_tile(const bf16_t* Ks, const bf16_t* Vs, int rb, const bf16x8 (&qf0)[4], const bf16x8 (&qf1)[4], f32x4 (&acc0)[8], f32x4 (&acc1)[8],
                                         float& m0, float& m1, float& ls0, float& ls1, const float* ckb, float ct0, float ct1, int tq0, int tq1, int kbase_t, bool mask0, bool mask1,
                                         int ln, int g, int q4, int p4) {
    f32x4 sc0[4], sc1[4];
    __builtin_amdgcn_s_setprio(1);
#pragma unroll
    for (int mt = 0; mt < 4; ++mt) { sc0[mt] = (f32x4){0.f, 0.f, 0.f, 0.f}; sc1[mt] = (f32x4){0.f, 0.f, 0.f, 0.f};
#pragma unroll
        for (int ks = 0; ks < 4; ++ks) { const bf16x8 a = *(const bf16x8*)(Ks + (rb + 16 * mt + ln) * 136 + 32 * ks + 8 * g);
            sc1[mt] = MFMA16(a, qf1[ks], sc1[mt]); if (BOTH) sc0[mt] = MFMA16(a, qf0[ks], sc0[mt]); } }
    __builtin_amdgcn_s_setprio(0);
    bf16x8 pb0[2], pb1[2];
    fox_softmax(sc1, acc1, m1, ls1, pb1, ckb, ct1, tq1, kbase_t, mask1, g);
    if (BOTH) fox_softmax(sc0, acc0, m0, ls0, pb0, ckb, ct0, tq0, kbase_t, mask0, g);
    __builtin_amdgcn_s_setprio(1);
#pragma unroll
    for (int a = 0; a < 2; ++a) {
        const int r0v = rb + 32 * a + 4 * g + q4;
#pragma unroll
        for (int vt = 0; vt < 8; ++vt) { const bf16x8 af = cat8(trrd(Vs + r0v * 144 + 16 * vt + 4 * p4), trrd(Vs + (r0v + 16) * 144 + 16 * vt + 4 * p4));
            acc1[vt] = MFMA16(af, pb1[a], acc1[vt]); if (BOTH) acc0[vt] = MFMA16(af, pb0[a], acc0[vt]); }
    }
    __builtin_amdgcn_s_setprio(0);
}
__device__ void fox_job(const P& p, int bh, int c, unsigned char* smem) {
    const int tid = lt_tid(), wid = __builtin_amdgcn_readfirstlane(tid >> 6), lane = tid & 63, ln = lane & 15, g = lane >> 4, q4 = (lane >> 2) & 3, p4 = lane & 3;
    const int wq = wid & 3, wk = wid >> 2, b = bh >> 2, h = bh & 3;
    bf16_t* Ks = (bf16_t*)smem;
    bf16_t* Vs = Ks + 2 * 128 * 136;
    float* ck = (float*)(Vs + 2 * 128 * 144);
    const bf16_t* proj = (const bf16_t*)(p.ws + OFF_PROJ); const float* cum = (const float*)(p.ws + OFF_CUM) + bh * LPF;
    const bf16_t* fkp = (const bf16_t*)(p.ws + OFF_FK); const bf16_t* fvp = (const bf16_t*)(p.ws + OFF_FV);
    const int r0 = 128 * c - 112 + 32 * wq;
    const bool val0 = r0 >= 0, val1 = r0 + 16 >= 0;
    const int tq0 = r0 + ln, tq1 = r0 + 16 + ln;
    bf16x8 qf0[4], qf1[4];
    { const bf16_t* q0p = proj + (size_t)rmap(b, max(tq0, 0)) * NPROJ + C_FXQ + h * 128 + 8 * g; const bf16_t* q1p = proj + (size_t)rmap(b, max(tq1, 0)) * NPROJ + C_FXQ + h * 128 + 8 * g;
#pragma unroll
      for (int ks = 0; ks < 4; ++ks) { qf0[ks] = *(const bf16x8*)(q0p + 32 * ks); qf1[ks] = *(const bf16x8*)(q1p + 32 * ks); } }
    const float ct0 = cum[112 + max(tq0, 0)] * LOG2E, ct1 = cum[112 + max(tq1, 0)] * LOG2E;
    f32x4 acc0[8], acc1[8];
#pragma unroll
    for (int vt = 0; vt < 8; ++vt) { acc0[vt] = (f32x4){0.f, 0.f, 0.f, 0.f}; acc1[vt] = (f32x4){0.f, 0.f, 0.f, 0.f}; }
    float m0 = -1e30f, m1 = -1e30f, ls0 = 0.f, ls1 = 0.f;
    const int nkt = 2 * c + 1, nit = c + 1;
    uint4 kr0, kr1, kr2, kr3, vr0, vr1, vr2, vr3; float cr = 0.f;
    const int srow = tid >> 4, sch = tid & 15;
#define FOX_G1(KR, VR, i, lp0) do { const int t_ = min(max((lp0) + srow + 32 * (i) - 112, 0), LT - 1); const size_t o_ = ((size_t)bh * LT + t_) * 128 + sch * 8; \
        KR = *(const uint4*)(fkp + o_); VR = *(const uint4*)(fvp + o_); } while (0)
#define FOX_GLOAD(it_) do { const int lp0_ = 64 * (1 + 2 * (it_)); FOX_G1(kr0, vr0, 0, lp0_); FOX_G1(kr1, vr1, 1, lp0_); FOX_G1(kr2, vr2, 2, lp0_); FOX_G1(kr3, vr3, 3, lp0_); \
        if (tid < 128) cr = -cum[min(lp0_ + tid, LPF - 1)] * LOG2E; } while (0)
#define FOX_S1(KR, VR, i, st_) do { *(uint4*)(Ks + ((st_) * 128 + srow + 32 * (i)) * 136 + sch * 8) = KR; *(uint4*)(Vs + ((st_) * 128 + srow + 32 * (i)) * 144 + sch * 8) = VR; } while (0)
#define FOX_LSTORE(st_) do { FOX_S1(kr0, vr0, 0, st_); FOX_S1(kr1, vr1, 1, st_); FOX_S1(kr2, vr2, 2, st_); FOX_S1(kr3, vr3, 3, st_); if (tid < 128) ck[(st_) * 128 + tid] = cr; } while (0)
    FOX_GLOAD(0); FOX_LSTORE(0);
    __syncthreads();
    for (int it = 0; it < nit; ++it) {
        const int st = it & 1;
        if (it + 1 < nit) FOX_GLOAD(it + 1);
        const int kt = 1 + 2 * it + wk;
        const bool need1 = val1 && kt <= nkt && (64 * kt <= 128 * c + 32 * wq + 31);
        if (need1) {
            const bool need0 = val0 && (64 * kt <= 128 * c + 32 * wq + 15);
            const int rb = st * 128 + wk * 64;
            const int kbase_t = 64 * kt - 112; const float* ckb = ck + st * 128 + wk * 64;
            const bool mask1 = (kt == 1) || (64 * kt + 63 > 128 * c + 32 * wq + 16), mask0 = (kt == 1) || (64 * kt + 63 > 128 * c + 32 * wq);
            if (need0) fox_tile<true>(Ks, Vs, rb, qf0, qf1, acc0, acc1, m0, m1, ls0, ls1, ckb, ct0, ct1, tq0, tq1, kbase_t, mask0, mask1, ln, g, q4, p4);
            else fox_tile<false>(Ks, Vs, rb, qf0, qf1, acc0, acc1, m0, m1, ls0, ls1, ckb, ct0, ct1, tq0, tq1, kbase_t, mask0, mask1, ln, g, q4, p4);
        }
        if (it + 1 < nit) FOX_LSTORE(st ^ 1);
        __syncthreads();
    }
#undef FOX_G1
#undef FOX_GLOAD
#undef FOX_S1
#undef FOX_LSTORE
    float* mg = (float*)smem;
    const int lane_m = lt_tid() & 63;
    if (wk == 1) {
        float* m0p = mg + ((wq * 2 + 0) * 34) * 64 + lane_m; float* m1p = mg + ((wq * 2 + 1) * 34) * 64 + lane_m;
#pragma unroll
        for (int vt = 0; vt < 8; ++vt)
#pragma unroll
            for (int j = 0; j < 4; ++j) { m0p[(vt * 4 + j) * 64] = acc0[vt][j]; m1p[(vt * 4 + j) * 64] = acc1[vt][j]; }
        m0p[32 * 64] = m0; m0p[33 * 64] = ls0; m1p[32 * 64] = m1; m1p[33 * 64] = ls1;
    }
    __syncthreads();
    if (wk == 0) {
#pragma unroll
        for (int sb = 0; sb < 2; ++sb) {
            if (!(sb ? val1 : val0)) continue;
            const float* mp = mg + ((wq * 2 + sb) * 34) * 64 + lane_m;
            const float ma = sb ? m1 : m0, la = sb ? ls1 : ls0, mb = mp[32 * 64], lb = mp[33 * 64];
            const float mt = fmaxf(ma, mb), fa = __builtin_amdgcn_exp2f(ma - mt), fb = __builtin_amdgcn_exp2f(mb - mt);
            float l = la * fa + lb * fb; l += __shfl_xor(l, 16); l += __shfl_xor(l, 32);
            const float inv = 1.f / l;
            int lne = lt_tid() & 15; const int tqe = 128 * c - 112 + 32 * wq + 16 * sb + lne;
            bf16_t* yo = (bf16_t*)(p.ws + OFF_ABUF) + (size_t)rmap(b, tqe) * DM + 1024 + h * 128;
#pragma unroll
            for (int vt = 0; vt < 8; ++vt) { const f32x4 av = sb ? acc1[vt] : acc0[vt]; float o[4];
#pragma unroll
                for (int j = 0; j < 4; ++j) o[j] = (av[j] * fa + mp[(vt * 4 + j) * 64] * fb) * inv;
                uint2 w; w.x = pk2(o[0], o[1]); w.y = pk2(o[2], o[3]); *(uint2*)(yo + 16 * vt + 4 * g) = w; }
        }
    }
    __syncthreads();
}

#define XB_TMO      128
#define XB_XCNT(j)  (256  + 64 * (j))
#define XB_XSUB(j)  (1280 + 64 * (j))
#define XB_XGEN(j)  (2304 + 64 * (j))
#define XB_TOP      3328
#define XB_TOPGEN   3392
#define XCD_BAR_WORDS 3456
#define XB_SPIN_CAP (1u << 18)
#define LAS __attribute__((address_space(3)))

__device__ __forceinline__ unsigned xb_ld(unsigned* p)              { return __hip_atomic_load(p, __ATOMIC_RELAXED, __HIP_MEMORY_SCOPE_AGENT); }
__device__ __forceinline__ unsigned xb_add(unsigned* p, unsigned v) { return __hip_atomic_fetch_add(p, v, __ATOMIC_RELAXED, __HIP_MEMORY_SCOPE_AGENT); }
__device__ __forceinline__ unsigned xb_xcc_id() { return (unsigned)__builtin_amdgcn_s_getreg((3 << 11) | 20) & 0xFu; }
#define XB_SPIN(cond, bar) do { unsigned _sp = 0; while (cond) { __builtin_amdgcn_s_sleep(1); \
    if ((++_sp & 255u) == 0u) { if (xb_ld(&(bar)[XB_TMO])) break; if (_sp > XB_SPIN_CAP) { atomicAdd(&(bar)[XB_TMO], 1u); break; } } } } while (0)

struct XcdBarrier {
    unsigned* bar; unsigned x;
    volatile LAS unsigned* st;
};

__device__ __forceinline__ XcdBarrier xcd_barrier_post(unsigned* bar, volatile LAS unsigned* st) {
    XcdBarrier b; b.bar = bar; b.x = xb_xcc_id(); b.st = st;
    if (threadIdx.x == 0) (void)xb_add(&bar[XB_XCNT(b.x)], 1u);
    return b;
}
__device__ __forceinline__ void xcd_barrier_complete(unsigned* bar, unsigned x, unsigned& nloc, unsigned& nx) {
    const unsigned G = gridDim.x * gridDim.y * gridDim.z;
    unsigned sum, cnt, mine, sp = 0u;
    for (;;) {
        sum = 0u; cnt = 0u; mine = 0u;
#pragma unroll
        for (unsigned j = 0; j < 16; ++j) { const unsigned c = xb_ld(&bar[XB_XCNT(j)]); sum += c; cnt += (c > 0u) ? 1u : 0u; mine = (j == x) ? c : mine; }
        if (sum == G) break;
        __builtin_amdgcn_s_sleep(1);
        if ((++sp & 255u) == 0u) { if (xb_ld(&bar[XB_TMO])) break; if (sp > XB_SPIN_CAP) { atomicAdd(&bar[XB_TMO], 1u); break; } }
    }
    nloc = mine > 0u ? mine : 1u; nx = cnt > 0u ? cnt : 1u;
}

__device__ __forceinline__ void xcd_barrier(const XcdBarrier& b) {
    asm volatile("s_waitcnt vmcnt(0)" ::: "memory");
    __syncthreads();
    if (threadIdx.x == 0) {
        unsigned* bar = b.bar;
        __builtin_amdgcn_s_waitcnt(0);
        unsigned nloc = b.st[0], nx = b.st[1];
        if (nloc == 0u) { xcd_barrier_complete(bar, b.x, nloc, nx); b.st[0] = nloc; b.st[1] = nx; }
        const unsigned old = xb_add(&bar[XB_XSUB(b.x)], 1u);
        const unsigned gen = old / nloc;
        if (old + 1u == (gen + 1u) * nloc) {
            __builtin_amdgcn_fence(__ATOMIC_RELEASE, "agent");
            asm volatile("s_waitcnt vmcnt(0)" ::: "memory");
            const unsigned og = xb_add(&bar[XB_TOP], 1u);
            const unsigned tg = og / nx;
            if (og + 1u == (tg + 1u) * nx) xb_add(&bar[XB_TOPGEN], 1u);
            else XB_SPIN(xb_ld(&bar[XB_TOPGEN]) == tg, bar);
            __builtin_amdgcn_fence(__ATOMIC_ACQUIRE, "agent");
            xb_add(&bar[XB_XGEN(b.x)], 1u);
            asm volatile("s_waitcnt vmcnt(0)" ::: "memory");
        } else {
            XB_SPIN(xb_ld(&bar[XB_XGEN(b.x)]) == gen, bar);
            __builtin_amdgcn_fence(__ATOMIC_ACQUIRE, "agent");
            asm volatile("s_waitcnt vmcnt(0)" ::: "memory");
        }
    }
    __syncthreads();
}


__device__ void phase_m1(const P& p, int l, unsigned char* smem) {
    for (int jb = blockIdx.x; jb < 1586; jb += gridDim.x) {
        if (jb < 16) fox_cum(p, l, jb, smem);
        else if (jb < 544) ml_pass1(p, l, jb - 16, smem);
        else if (jb < 1072) { s5_pass1(p, l, jb - 544, smem); __syncthreads(); }
        else pool_pre(p, jb - 1072);
    }
}
__device__ void phase_m2(const P& p, int l) {
    for (int jb = blockIdx.x; jb < 144; jb += gridDim.x) { if (jb < 128) ml_scan(p, jb); else s5_carry(p, l, jb - 128); }
}
__device__ __forceinline__ void job_publish(unsigned* flag) {
    asm volatile("s_waitcnt vmcnt(0)" ::: "memory");
    __syncthreads();
    if (lt_tid() == 0) { __builtin_amdgcn_fence(__ATOMIC_RELEASE, "agent"); asm volatile("s_waitcnt vmcnt(0)" ::: "memory");
        (void)__hip_atomic_fetch_add(flag, 1u, __ATOMIC_RELAXED, __HIP_MEMORY_SCOPE_AGENT); }
}
__device__ __forceinline__ void job_wait(unsigned* flags, int i, volatile int* s_sat) {
    if (s_sat[i]) return;
    if (lt_tid() == 0) { const unsigned need = i < 16 ? 8u : 4u; unsigned sp = 0u;
        while (__hip_atomic_load(flags + i, __ATOMIC_RELAXED, __HIP_MEMORY_SCOPE_AGENT) < need) { __builtin_amdgcn_s_sleep(4); if (++sp > (1u << 20)) break; } }
    __syncthreads();
    { const int t_ = lt_tid(); if (t_ < 20) s_sat[t_] = __hip_atomic_load(flags + t_, __ATOMIC_RELAXED, __HIP_MEMORY_SCOPE_AGENT) >= (t_ < 16 ? 8u : 4u) ? 1 : 0; }
    __builtin_amdgcn_fence(__ATOMIC_ACQUIRE, "agent");
    asm volatile("s_waitcnt vmcnt(0)" ::: "memory");
    __syncthreads();
}
__device__ void phase_m3(const P& p, int l, unsigned char* smem) {
    __shared__ int s_job; __shared__ int s_sat[20];
    unsigned* ctr = (unsigned*)(p.ws + OFF_CTR) + l * 16;
    unsigned* fml = (unsigned*)(p.ws + OFF_CTR) + 64 + l * 32;
    { const int t_ = lt_tid(); if (t_ < 20) s_sat[t_] = 0; }
    __syncthreads();
    for (;;) {
        if (lt_tid() == 0) s_job = (int)atomicAdd(ctr, 1u);
        __syncthreads();
        const int jb = s_job;
        __syncthreads();
        if (jb >= 1728) break;
        if (jb < 128) { ml_scan(p, jb); job_publish(fml + (jb >> 3)); }
        else if (jb < 144) { s5_carry(p, l, jb - 128); job_publish(fml + 16 + ((jb - 128) >> 2)); }
        else if (jb < 672) { const int k = jb - 144; fox_job(p, k & 15, 32 - (k >> 4), smem); }
        else if (jb < 1200) { const int j = jb - 672; job_wait(fml, j / NCH, s_sat); ml_pass2(p, l, j, smem); }
        else { const int j = jb - 1200; job_wait(fml, 16 + j / 132, s_sat); s5_pass2(p, l, j, smem); __syncthreads(); }
    }
}

__global__ __launch_bounds__(512, 2) void mega(P p, int ph0, int ph1) {
    extern __shared__ __attribute__((aligned(16))) unsigned char smem[];
    cg::grid_group grid = cg::this_grid();
    __shared__ uint4 xb_words;
    if (threadIdx.x == 0) xb_words = make_uint4(0u, 0u, 0u, 0u);
    __syncthreads();
    const XcdBarrier xb = xcd_barrier_post((unsigned*)(p.ws + OFF_XBAR), (volatile LAS unsigned*)&xb_words);
    bf16_t* abuf = (bf16_t*)(p.ws + OFF_ABUF); bf16_t* fbuf = (bf16_t*)(p.ws + OFF_FBUF);
    for (int ph = ph0; ph < ph1; ++ph) {
        if (ph > 0 && (ph - 1) % 10 == 2) continue;
        if (ph > ph0) { if (ph1 < 0) grid.sync(); else xcd_barrier(xb); }
        if (ph == 0) {
            convert_phase(p, 0, smem); row_first(p);
            continue;
        }
        const int l = (ph - 1) / 10, s = (ph - 1) % 10;
        switch (s) {
        case 0: { EpiG1 E; E.O = (bf16_t*)(p.ws + OFF_PROJ); E.gates = (float*)(p.ws + OFF_GATES); E.fk = (bf16_t*)(p.ws + OFF_FK); E.fv = (bf16_t*)(p.ws + OFF_FV); run_gemm(smem, abuf, (const bf16_t*)(p.ws + OFF_WIN), NIN, DM, E, 0); } break;
        case 1: phase_m1(p, l, smem); break;
        case 2: phase_m2(p, l); break;
        case 3: phase_m3(p, l, smem);
                { EpiPool E2; E2.O = abuf; E2.scale = p.in[I_POOLS] + l * 512; run_gemm(smem, (const bf16_t*)(p.ws + OFF_POOLED), (const bf16_t*)(p.ws + OFF_WPOOL), 512, 512, E2, 60, l == DEPTH - 1 ? NMAIN : MP); } break;
        case 4: { EpiGLU E; E.O = abuf; E.bias = p.in[I_GLUB] + l * 1024; run_gemm(smem, (const bf16_t*)(p.ws + OFF_SY), (const bf16_t*)(p.ws + OFF_WGLU), 1024, 512, E, 0, l == DEPTH - 1 ? NMAIN : MP); } break;
        case 5: { EpiB<0> E; E.O = fbuf; E.ldc = DM; run_gemm(smem, abuf, (const bf16_t*)(p.ws + OFF_WOUT), DM, DM, E, 0, NMAIN);
                  if (l < DEPTH - 1) skinny_meta<2>(smem, abuf, (const bf16_t*)(p.ws + OFF_WOUT), DM, DM, fbuf); } break;
        case 6: row_postmix(p, l); break;
        case 7: { EpiB<1> E; E.O = fbuf; E.ldc = DFF; run_gemm(smem, abuf, (const bf16_t*)(p.ws + OFF_W1), DFF, DM, E, 0, NMAIN);
                  if (l < DEPTH - 1) skinny_meta<1>(smem, abuf, (const bf16_t*)(p.ws + OFF_W1), DFF, DM, fbuf); } break;
        case 8: { EpiB<0> E; E.O = abuf; E.ldc = DM; run_gemm(smem, fbuf, (const bf16_t*)(p.ws + OFF_W2), DM, DFF, E, 0, NMAIN);
                  if (l < DEPTH - 1) skinny_meta<2>(smem, fbuf, (const bf16_t*)(p.ws + OFF_W2), DM, DFF, abuf); } break;
        case 9: row_postffn(p, l); if (l + 1 < DEPTH) convert_phase(p, l + 1, smem); break;
        }
    }
}

extern "C" void kernel_launch(void* const* d_in, const int* in_sizes, int n_in, void* d_out, int out_size, void* d_ws, size_t ws_size, hipStream_t stream) {
    constexpr size_t kDynLds = 147456;
    static int grid_blocks = 0;
    if (!grid_blocks) {
        hipFuncSetAttribute((const void*)mega, hipFuncAttributeMaxDynamicSharedMemorySize, (int)kDynLds);
        int dev = 0, cus = 0, per_cu = 0;
        hipGetDevice(&dev);
        hipDeviceGetAttribute(&cus, hipDeviceAttributeMultiprocessorCount, dev);
        hipOccupancyMaxActiveBlocksPerMultiprocessor(&per_cu, mega, 512, kDynLds);
        if (per_cu < 1) per_cu = 1;
        grid_blocks = cus * (per_cu > 1 ? 1 : per_cu);
    }
    P p{};
    for (int i = 0; i < N_IN; ++i) p.in[i] = (const float*)d_in[i];
    p.out = (float*)d_out; p.ws = (unsigned char*)d_ws;
    (void)hipMemsetAsync((unsigned char*)d_ws + OFF_CTR, 0, 512 + 3456 * 4, stream);
    int ph0 = 0, ph1 = 1 + 10 * DEPTH;
    void* args[] = {&p, &ph0, &ph1};
    hipError_t e = hipLaunchCooperativeKernel((const void*)mega, dim3(grid_blocks), dim3(512), args, kDynLds, stream);
    if (e != hipSuccess) fprintf(stderr, "cooperative launch failed: %s (grid %d)\n", hipGetErrorString(e), grid_blocks);
}
```

```cpp
#include <hip/hip_runtime.h>
#include <hip/hip_cooperative_groups.h>
#include <cstdio>
namespace cg = cooperative_groups;

__device__ __forceinline__ int lt_tid() { int t = threadIdx.x; asm volatile("" : "+v"(t)); return t; }
namespace pg8 {
#define PG8_LAS __attribute__((address_space(3)))
typedef unsigned short bf16_t;
typedef short bf16x8 __attribute__((ext_vector_type(8)));
typedef float f32x4 __attribute__((ext_vector_type(4)));
typedef unsigned u32x4 __attribute__((ext_vector_type(4)));
constexpr int BM = 256, BK = 64, HALF = 128, HTB = HALF * BK * 2  , STAGE_BYTES = 8 * HTB, NXCD = 8, WGM = 4  ;

__host__ __device__ __forceinline__ int lds_byte(int r, int c) { const int st = (r >> 4) * 2 + (c >> 5), rr = r & 15, cc = c & 31, ob = rr * 64 + cc * 2; return st * 1024 + (ob ^ (((ob >> 9) & 1) << 5)); }
__host__ __device__ __forceinline__ void stage_rc(int b, int& R, int& C) { const int st = b / 1024, sb = b % 1024, swz = sb ^ (((sb >> 9) & 1) << 5); R = (st >> 1) * 16 + swz / 64; C = (st & 1) * 32 + (swz % 64) / 2; }
__host__ __device__ __forceinline__ int perm32(int rho) { const int n = rho >> 4, i = rho & 15; return 8 * (i >> 2) + 4 * n + (i & 3); }

struct Unit { int pm, pn; };
struct Gemm { const bf16_t* A; const bf16_t* Bt; int M, N, K; };

struct StaticOrder {
    int nM, nN, nwg, G, c;
    __host__ __device__ void init(int M, int N, int G_, int c_) { nM = M / BM; nN = N / BM; nwg = nM * nN; G = G_; c = c_; }
    __host__ __device__ bool next(int i, Unit& u) const {
        const long L = (long)i * G + c; if (L >= nwg) return false;
        int wgid = (int)L; { const int q = nwg / NXCD, r = nwg % NXCD, xcd = wgid % NXCD, off = wgid / NXCD; wgid = (xcd < r ? xcd * (q + 1) : r * (q + 1) + (xcd - r) * q) + off; }
        const int nig = WGM * nN, gid = wgid / nig, fm = gid * WGM, gsz = (nM - fm) < WGM ? (nM - fm) : WGM;
        u.pm = fm + ((wgid % nig) % gsz); u.pn = (wgid % nig) / gsz; return true;
    }
    __device__ __forceinline__ void a_ready(const Unit&) const {}
    __device__ __forceinline__ void done(const Unit&) const {}
};
__device__ __forceinline__ unsigned cvt_pk_bf16(float lo, float hi) { unsigned r; asm volatile("v_cvt_pk_bf16_f32 %0, %1, %2" : "=v"(r) : "v"(lo), "v"(hi)); return r; }

template <class Epi, class Sched, bool STAMP = false>
__device__ __forceinline__ void gemm_phase(PG8_LAS unsigned char* lds, const Gemm g, const Sched& S, const Epi& E, unsigned long long* stamps) {
    const int tid = lt_tid(), wid = __builtin_amdgcn_readfirstlane(tid >> 6), lane = tid & 63, wr = wid >> 2, wc = wid & 3, fr = lane & 15, fq = lane >> 4;
    const int K = g.K, nt = K / BK;
    int ts_lo = 0, ts_hi = 0, nts = 0; const unsigned long long rt_entry = STAMP ? (unsigned long long)wall_clock64() : 0ull;
#define PG8_STAMP() do { if (STAMP && wid == 0 && nts < 64) { const unsigned long long _c = (unsigned long long)clock64(); \
        ts_lo = (lane == nts) ? (int)(unsigned)_c : ts_lo; ts_hi = (lane == nts) ? (int)(unsigned)(_c >> 32) : ts_hi; ++nts; } } while (0)
    PG8_STAMP();
    unsigned voffA[2], voffB[2];
#pragma unroll
    for (int i = 0; i < 2; ++i) { int R, C; stage_rc(tid * 16 + i * 8192, R, C); const int Rb = Epi::PERM ? ((R & ~31) + perm32(R & 31)) : R;
        voffA[i] = (unsigned)(R * K + C) * 2u; voffB[i] = (unsigned)(Rb * K + C) * 2u; }
    const size_t kstep = (size_t)(BK * 2);
    const size_t hstep = (size_t)HALF * K * 2;
    const size_t tstep = 2 * hstep;
    const unsigned ldsw = (unsigned)wid * 1024u;
    const int aoff = lds_byte(wr * 64 + fr, fq * 8), boff = lds_byte(wc * 32 + fr, fq * 8);
#define PG8_SA(b, h) (((b) * 2 + (h)) * HTB)
#define PG8_SB(b, h) ((4 + (b) * 2 + (h)) * HTB)
#define PG8_STAGE(bufoff, gbase, voff) do { _Pragma("unroll") for (int _i = 0; _i < 2; ++_i) \
        __builtin_amdgcn_global_load_lds((const unsigned*)((const char*)(gbase) + (voff)[_i]), (PG8_LAS unsigned*)(lds + (bufoff) + ldsw + _i * 8192), 16, 0, 0); } while (0)
#define PG8_LDA(dst, b, h) do { _Pragma("unroll") for (int m = 0; m < 4; ++m) _Pragma("unroll") for (int k = 0; k < 2; ++k) dst[m][k] = *(const PG8_LAS bf16x8*)(lds + PG8_SA(b, h) + aoff + m * 2048 + k * 1024); } while (0)
#define PG8_LDB(dst, b, h) do { _Pragma("unroll") for (int n = 0; n < 2; ++n) _Pragma("unroll") for (int k = 0; k < 2; ++k) dst[n][k] = *(const PG8_LAS bf16x8*)(lds + PG8_SB(b, h) + boff + n * 2048 + k * 1024); } while (0)
#define PG8_MMA(ai, bj, At, Bt) do { __builtin_amdgcn_s_setprio(1); _Pragma("unroll") for (int m = 0; m < 4; ++m) _Pragma("unroll") for (int n = 0; n < 2; ++n) _Pragma("unroll") for (int k = 0; k < 2; ++k) \
        acc[ai][bj][m][n] = __builtin_amdgcn_mfma_f32_16x16x32_bf16(Bt[n][k], At[m][k], acc[ai][bj][m][n], 0, 0, 0); __builtin_amdgcn_s_setprio(0); } while (0)
#define PG8_WAIT_V(n) asm volatile("s_waitcnt vmcnt(" #n ")" ::: "memory")
#define PG8_WAIT_L(n) asm volatile("s_waitcnt lgkmcnt(" #n ")" ::: "memory")
#define PG8_BAR __builtin_amdgcn_s_barrier()
#define PG8_SCHED __builtin_amdgcn_sched_barrier(0)
    Unit cur, nxt; int ui = 0;
    if (!S.next(0, cur)) return;
    f32x4 acc[2][2][4][2];
#pragma unroll
    for (int a = 0; a < 2; ++a)
#pragma unroll
        for (int b = 0; b < 2; ++b)
#pragma unroll
            for (int m = 0; m < 4; ++m)
#pragma unroll
                for (int n = 0; n < 2; ++n) acc[a][b][m][n] = (f32x4){0.f, 0.f, 0.f, 0.f};
    bf16x8 At[4][2], B0[2][2], B1[2][2];
    const char* cA = (const char*)g.A + (size_t)cur.pm * tstep; const char* cB = (const char*)g.Bt + (size_t)cur.pn * tstep;
    S.a_ready(cur);
    PG8_STAGE(PG8_SB(0, 0), cB, voffB); PG8_STAGE(PG8_SA(0, 0), cA, voffA); PG8_STAGE(PG8_SB(0, 1), cB + hstep, voffB); PG8_STAGE(PG8_SA(0, 1), cA + hstep, voffA);
    if (wr == 1) PG8_BAR;
    PG8_WAIT_V(4); PG8_BAR;
    PG8_STAGE(PG8_SB(1, 0), cB + kstep, voffB); PG8_STAGE(PG8_SA(1, 0), cA + kstep, voffA); PG8_STAGE(PG8_SB(1, 1), cB + hstep + kstep, voffB);
    PG8_WAIT_V(6); PG8_BAR;
    PG8_STAMP();
    for (;;) {
        const bool has_next = S.next(ui + 1, nxt);
        const char* nA = has_next ? (const char*)g.A + (size_t)nxt.pm * tstep : cA; const char* nB = has_next ? (const char*)g.Bt + (size_t)nxt.pn * tstep : cB;
        for (int t = 0; t < nt; t += 2) {
            const bool last = (t == nt - 2);
            const char* a1 = cA + (size_t)(t + 1) * kstep;
            const char* a2 = last ? nA : cA + (size_t)(t + 2) * kstep; const char* b2 = last ? nB : cB + (size_t)(t + 2) * kstep;
            const char* a3 = a2 + kstep; const char* b3 = b2 + kstep;
            if (last && has_next) S.a_ready(nxt);
            PG8_LDB(B0, 0, 0); PG8_SCHED; PG8_LDA(At, 0, 0); PG8_STAGE(PG8_SA(1, 1), a1 + hstep, voffA);
            PG8_WAIT_L(8); PG8_BAR; PG8_WAIT_L(0); PG8_MMA(0, 0, At, B0); PG8_BAR; PG8_SCHED;
            PG8_LDB(B1, 0, 1); PG8_STAGE(PG8_SB(0, 0), b2, voffB);
            PG8_BAR; PG8_WAIT_L(0); PG8_MMA(0, 1, At, B1); PG8_BAR;
            PG8_LDA(At, 0, 1); PG8_STAGE(PG8_SA(0, 0), a2, voffA);
            PG8_BAR; PG8_WAIT_L(0); PG8_MMA(1, 0, At, B0); PG8_BAR; PG8_SCHED;
            PG8_STAGE(PG8_SB(0, 1), b2 + hstep, voffB);
            PG8_WAIT_V(6); PG8_BAR; PG8_MMA(1, 1, At, B1); PG8_BAR;
            PG8_LDB(B0, 1, 0); PG8_SCHED; PG8_LDA(At, 1, 0); PG8_STAGE(PG8_SA(0, 1), a2 + hstep, voffA);
            PG8_WAIT_L(8); PG8_BAR; PG8_WAIT_L(0); PG8_MMA(0, 0, At, B0); PG8_BAR; PG8_SCHED;
            PG8_LDB(B1, 1, 1); PG8_STAGE(PG8_SB(1, 0), b3, voffB);
            PG8_BAR; PG8_WAIT_L(0); PG8_MMA(0, 1, At, B1); PG8_BAR;
            PG8_LDA(At, 1, 1); PG8_STAGE(PG8_SA(1, 0), a3, voffA);
            PG8_BAR; PG8_WAIT_L(0); PG8_MMA(1, 0, At, B0); PG8_BAR; PG8_SCHED;
            PG8_STAGE(PG8_SB(1, 1), b3 + hstep, voffB);
            PG8_WAIT_V(6); PG8_BAR; PG8_MMA(1, 1, At, B1); PG8_BAR;
        }
        PG8_STAMP();
        if constexpr (!Epi::AFTER_DRAIN) { E(acc, cur, wr, wc, fr, fq); S.done(cur); }
        PG8_STAMP();
        if (!has_next) break;
#pragma unroll
        for (int a = 0; a < 2; ++a)
#pragma unroll
            for (int b = 0; b < 2; ++b)
#pragma unroll
                for (int m = 0; m < 4; ++m)
#pragma unroll
                    for (int n = 0; n < 2; ++n) acc[a][b][m][n] = (f32x4){0.f, 0.f, 0.f, 0.f};
        cur = nxt; cA = nA; cB = nB; ++ui;
    }
    PG8_WAIT_V(0);
    if (wr == 0) PG8_BAR;
    PG8_BAR;
    if constexpr (Epi::AFTER_DRAIN) { E.fused(acc, cur, wr, wc, fr, fq, lds, wid, lane); S.done(cur); }
    PG8_STAMP();
    if (STAMP && wid == 0) { stamps[lane] = lane < nts ? (((unsigned long long)(unsigned)ts_hi << 32) | (unsigned)ts_lo) : 0ull;
        if (lane == 62) stamps[62] = rt_entry; if (lane == 63) stamps[63] = (unsigned long long)wall_clock64(); }
#undef PG8_STAMP
#undef PG8_SA
#undef PG8_SB
#undef PG8_STAGE
#undef PG8_LDA
#undef PG8_LDB
#undef PG8_MMA
#undef PG8_WAIT_V
#undef PG8_WAIT_L
#undef PG8_BAR
#undef PG8_SCHED
}
}

using pg8::bf16_t; using pg8::bf16x8; using pg8::f32x4; using pg8::u32x4;
typedef short s16x4 __attribute__((ext_vector_type(4)));
#define LAS3 __attribute__((address_space(3)))

constexpr int NB = 4, LT = 4112, DM = 2048, MR = NB * LT  , MP = 16640, NMAIN = 16384, NCH = 33, LPF = 4224;
constexpr int NPROJ = 3584, NIN = 4864, DFF = 8192, DEPTH = 2;
constexpr int C_S5U = 0, C_MLQ = 512, C_MLK = 1024, C_MLV = 1536, C_MLO = 2048, C_FXQ = 2560, C_PLU = 3072;
constexpr float EPS = 1e-6f, NEGB = -1e30f, LOG2E = 1.4426950408889634f;

enum { I_X = 0, I_META, I_GPREMIX, I_GPOSTMIX, I_GPREFFN, I_GPOSTFFN, I_WIN, I_MLGB, I_FXGB, I_LRE, I_LIM, I_LOGDT, I_BRE, I_BIM,
       I_CRE, I_CIM, I_SD, I_GLUW, I_GLUB, I_CONVW, I_NORMG, I_POOLW, I_POOLS, I_WOUT, I_W1, I_W2, N_IN };
struct P { const float* in[N_IN]; float* out; unsigned char* ws; };

constexpr size_t AL(size_t x) { return (x + 255) & ~(size_t)255; }
constexpr size_t OFF_WIN = 0;
constexpr size_t OFF_WOUT = OFF_WIN + AL((size_t)NIN * DM * 2);
constexpr size_t OFF_W1 = OFF_WOUT + AL((size_t)DM * DM * 2);
constexpr size_t OFF_W2 = OFF_W1 + AL((size_t)DFF * DM * 2);
constexpr size_t OFF_WGLU = OFF_W2 + AL((size_t)DM * DFF * 2);
constexpr size_t OFF_WPOOL = OFF_WGLU + AL((size_t)1024 * 512 * 2);
constexpr size_t OFF_ABUF = OFF_WPOOL + AL((size_t)512 * 512 * 2);
constexpr size_t OFF_FBUF = OFF_ABUF + AL((size_t)MP * DM * 2);
constexpr size_t OFF_PROJ = OFF_FBUF;
constexpr size_t OFF_QC = OFF_PROJ + AL((size_t)MP * NPROJ * 2);
constexpr size_t OFF_KC = OFF_QC + AL((size_t)MR * 512 * 2);
constexpr size_t OFF_CLOC = OFF_KC + AL((size_t)MR * 512 * 2);
constexpr size_t OFF_SY = OFF_CLOC + AL((size_t)528 * 16384 * 4);
constexpr size_t OFF_POOLED = OFF_SY + AL((size_t)MP * 512 * 2);
constexpr size_t OFF_FK = OFF_POOLED + AL((size_t)MP * 512 * 2);
constexpr size_t OFF_FV = OFF_FK + AL((size_t)16 * LT * 128 * 2);
constexpr size_t OFF_FEND = OFF_FV + AL((size_t)16 * LT * 128 * 2);
constexpr size_t OFF_SMALL = OFF_FBUF + AL((size_t)MP * DFF * 2);
static_assert(OFF_FEND <= OFF_SMALL, "mixer scratch must fit inside FBUF");
constexpr size_t OFF_GATES = OFF_SMALL;
constexpr size_t OFF_CUM = OFF_GATES + AL((size_t)MP * 16 * 4);
constexpr size_t OFF_BCUM = OFF_CUM + AL((size_t)16 * LPF * 4);
constexpr size_t OFF_MLI = OFF_BCUM + AL((size_t)16 * LPF * 4);
constexpr size_t OFF_MLG = OFF_MLI + AL((size_t)16 * LPF * 4);
constexpr size_t OFF_MLM = OFF_MLG + AL(528 * 4);
constexpr size_t OFF_MST = OFF_MLM + AL(528 * 4);
constexpr size_t OFF_NLOC = OFF_MST + AL(528 * 4);
constexpr size_t OFF_S5E = OFF_NLOC + AL((size_t)528 * 128 * 4);
constexpr size_t OFF_S5IN = OFF_S5E + AL((size_t)NB * NCH * 2048 * 8);
constexpr size_t OFF_CTR = OFF_S5IN + AL((size_t)NB * NCH * 2048 * 8);
constexpr size_t OFF_XBAR = OFF_CTR + 512;
constexpr size_t OFF_HB = OFF_XBAR + AL(3456 * 4 + 256);
constexpr size_t OFF_END = OFF_HB + AL((size_t)MP * DM * 2);
static_assert(OFF_END <= (size_t)512 * 1024 * 1024, "workspace budget");

__device__ __forceinline__ float bf2f(unsigned short h) { return __uint_as_float(((unsigned)h) << 16); }
__device__ __forceinline__ unsigned pk2(float lo, float hi) { return pg8::cvt_pk_bf16(lo, hi); }
__device__ __forceinline__ float logsig(float x) { return fminf(x, 0.f) - log1pf(expf(-fabsf(x))); }
__device__ __forceinline__ float sigm(float x) { return 1.f / (1.f + __expf(-x)); }
__device__ __forceinline__ float wsum(float v) { for (int o = 32; o > 0; o >>= 1) v += __shfl_xor(v, o); return v; }
__device__ __forceinline__ float wmaxf(float v) { for (int o = 32; o > 0; o >>= 1) v = fmaxf(v, __shfl_xor(v, o)); return v; }
__device__ __forceinline__ int rmap(int b, int t) { return t >= 16 ? b * 4096 + (t - 16) : NMAIN + b * 16 + t; }
__device__ __forceinline__ bf16_t* hrow(const P& p, int r) { return (bf16_t*)(p.ws + OFF_HB) + (size_t)r * DM; }
__device__ __forceinline__ void st4bf(bf16_t* q, f32x4 v) { uint2 w; w.x = pk2(v[0], v[1]); w.y = pk2(v[2], v[3]); *(uint2*)q = w; }
__device__ __forceinline__ s16x4 trrd(const bf16_t* a) { return __builtin_amdgcn_ds_read_tr16_b64_v4i16((LAS3 s16x4*)a); }
__device__ __forceinline__ bf16x8 cat8(s16x4 a, s16x4 b) { return (bf16x8){a[0], a[1], a[2], a[3], b[0], b[1], b[2], b[3]}; }
#define MFMA16(A, B, C) __builtin_amdgcn_mfma_f32_16x16x32_bf16(A, B, C, 0, 0, 0)

struct EpiG1 {
    static constexpr bool PERM = true, AFTER_DRAIN = false;
    bf16_t* O; float* gates; bf16_t* fk; bf16_t* fv;
    __device__ __forceinline__ void operator()(const f32x4 (&acc)[2][2][4][2], const pg8::Unit& u, int wr, int wc, int fr_, int fq_) const {
        int fr = fr_, fq = fq_; asm volatile("" : "+v"(fr), "+v"(fq));
        const int row0 = u.pm * 256 + wr * 64 + fr;
        if (u.pn >= 12 && u.pn < 16) {
            bf16_t* dstb = (u.pn >= 14 ? fv : fk) + wc * 32 + 8 * fq; const int h0 = (u.pn & 1) * 2;
#pragma unroll
            for (int ai = 0; ai < 2; ++ai)
#pragma unroll
                for (int m = 0; m < 4; ++m) { const int r = row0 + ai * 128 + m * 16; if (r >= MR) continue;
                    const int b = r < NMAIN ? (r >> 12) : ((r - NMAIN) >> 4), t = r < NMAIN ? (r & 4095) + 16 : ((r - NMAIN) & 15);
#pragma unroll
                    for (int bj = 0; bj < 2; ++bj) { const f32x4 v0 = acc[ai][bj][m][0], v1 = acc[ai][bj][m][1];
                        u32x4 w; w.x = pk2(v0[0], v0[1]); w.y = pk2(v0[2], v0[3]); w.z = pk2(v1[0], v1[1]); w.w = pk2(v1[2], v1[3]);
                        *(u32x4*)(dstb + ((size_t)((b * 4 + h0 + bj) * LT + t)) * 128) = w; } }
        } else if (u.pn < 18) {
            const int col0 = (u.pn < 12 ? u.pn : u.pn - 4) * 256 + wc * 32 + 8 * fq;
#pragma unroll
            for (int ai = 0; ai < 2; ++ai)
#pragma unroll
                for (int m = 0; m < 4; ++m) { bf16_t* rowp = O + (size_t)(row0 + ai * 128 + m * 16) * NPROJ + col0;
#pragma unroll
                    for (int bj = 0; bj < 2; ++bj) { const f32x4 v0 = acc[ai][bj][m][0], v1 = acc[ai][bj][m][1];
                        u32x4 w; w.x = pk2(v0[0], v0[1]); w.y = pk2(v0[2], v0[3]); w.z = pk2(v1[0], v1[1]); w.w = pk2(v1[2], v1[3]);
                        *(u32x4*)(rowp + bj * 128) = w; } }
        } else if (wc == 0 && fq < 2) {
#pragma unroll
            for (int ai = 0; ai < 2; ++ai)
#pragma unroll
                for (int m = 0; m < 4; ++m) { float* gp = gates + (size_t)(row0 + ai * 128 + m * 16) * 16 + 8 * fq;
                    *(f32x4*)gp = acc[ai][0][m][0]; *(f32x4*)(gp + 4) = acc[ai][0][m][1]; }
        }
    }
};
template <int ACT> struct EpiB {
    static constexpr bool PERM = true, AFTER_DRAIN = false;
    bf16_t* O; int ldc;
    __device__ __forceinline__ void operator()(const f32x4 (&acc)[2][2][4][2], const pg8::Unit& u, int wr, int wc, int fr_, int fq_) const {
        int fr = fr_, fq = fq_; asm volatile("" : "+v"(fr), "+v"(fq));
        const int row0 = u.pm * 256 + wr * 64 + fr, col0 = u.pn * 256 + wc * 32 + 8 * fq;
#pragma unroll
        for (int ai = 0; ai < 2; ++ai)
#pragma unroll
            for (int m = 0; m < 4; ++m) { bf16_t* rowp = O + (size_t)(row0 + ai * 128 + m * 16) * ldc + col0;
#pragma unroll
                for (int bj = 0; bj < 2; ++bj) { f32x4 v0 = acc[ai][bj][m][0], v1 = acc[ai][bj][m][1];
                    if (ACT == 1) {
#pragma unroll
                        for (int j = 0; j < 4; ++j) { const float a = fmaxf(v0[j], 0.f), b = fmaxf(v1[j], 0.f); v0[j] = a * a; v1[j] = b * b; } }
                    u32x4 w; w.x = pk2(v0[0], v0[1]); w.y = pk2(v0[2], v0[3]); w.z = pk2(v1[0], v1[1]); w.w = pk2(v1[2], v1[3]);
                    if (ACT == 1) __builtin_nontemporal_store(w, (u32x4*)(rowp + bj * 128)); else *(u32x4*)(rowp + bj * 128) = w; } }
    }
};
struct EpiGLU {
    static constexpr bool PERM = true, AFTER_DRAIN = false;
    bf16_t* O; const float* bias;
    __device__ __forceinline__ void operator()(const f32x4 (&acc)[2][2][4][2], const pg8::Unit& u, int wr, int wc, int fr_, int fq_) const {
        int fr = fr_, fq = fq_; asm volatile("" : "+v"(fr), "+v"(fq));
        const int row0 = u.pm * 256 + wr * 64 + fr, oc = u.pn * 128 + wc * 32 + 8 * fq;
        const f32x4 bv0 = *(const f32x4*)(bias + oc), bv1 = *(const f32x4*)(bias + oc + 4), bg0 = *(const f32x4*)(bias + 512 + oc), bg1 = *(const f32x4*)(bias + 512 + oc + 4);
#pragma unroll
        for (int ai = 0; ai < 2; ++ai)
#pragma unroll
            for (int m = 0; m < 4; ++m) {
                f32x4 v0 = acc[ai][0][m][0] + bv0, v1 = acc[ai][0][m][1] + bv1; const f32x4 g0 = acc[ai][1][m][0] + bg0, g1 = acc[ai][1][m][1] + bg1;
#pragma unroll
                for (int j = 0; j < 4; ++j) { v0[j] *= sigm(g0[j]); v1[j] *= sigm(g1[j]); }
                u32x4 w; w.x = pk2(v0[0], v0[1]); w.y = pk2(v0[2], v0[3]); w.z = pk2(v1[0], v1[1]); w.w = pk2(v1[2], v1[3]);
                *(u32x4*)(O + (size_t)(row0 + ai * 128 + m * 16) * DM + oc) = w; }
    }
};
struct EpiPool {
    static constexpr bool PERM = true, AFTER_DRAIN = false;
    bf16_t* O; const float* scale;
    __device__ __forceinline__ void operator()(const f32x4 (&acc)[2][2][4][2], const pg8::Unit& u, int wr, int wc, int fr_, int fq_) const {
        int fr = fr_, fq = fq_; asm volatile("" : "+v"(fr), "+v"(fq));
        const int row0 = u.pm * 256 + wr * 64 + fr, col0 = u.pn * 256 + wc * 32 + 8 * fq;
#pragma unroll
        for (int bj = 0; bj < 2; ++bj) { const f32x4 s0 = *(const f32x4*)(scale + col0 + bj * 128), s1 = *(const f32x4*)(scale + col0 + bj * 128 + 4);
#pragma unroll
            for (int ai = 0; ai < 2; ++ai)
#pragma unroll
                for (int m = 0; m < 4; ++m) { const f32x4 v0 = acc[ai][bj][m][0] * s0, v1 = acc[ai][bj][m][1] * s1;
                    u32x4 w; w.x = pk2(v0[0], v0[1]); w.y = pk2(v0[2], v0[3]); w.z = pk2(v1[0], v1[1]); w.w = pk2(v1[2], v1[3]);
                    *(u32x4*)(O + (size_t)(row0 + ai * 128 + m * 16) * DM + 1536 + col0 + bj * 128) = w; } }
    }
};
struct EpiF32 {
    static constexpr bool PERM = false, AFTER_DRAIN = false;
    float* C; int ldc;
    __device__ __forceinline__ void operator()(const f32x4 (&acc)[2][2][4][2], const pg8::Unit& u, int wr, int wc, int fr_, int fq_) const {
        int fr = fr_, fq = fq_; asm volatile("" : "+v"(fr), "+v"(fq));
        const int row0 = u.pm * 256 + wr * 64 + fr, col0 = u.pn * 256 + wc * 32 + 4 * fq;
#pragma unroll
        for (int ai = 0; ai < 2; ++ai)
#pragma unroll
            for (int m = 0; m < 4; ++m) { float* rowp = C + (size_t)(row0 + ai * 128 + m * 16) * ldc + col0;
#pragma unroll
                for (int bj = 0; bj < 2; ++bj)
#pragma unroll
                    for (int n = 0; n < 2; ++n) *(f32x4*)(rowp + bj * 128 + n * 16) = acc[ai][bj][m][n]; }
    }
};
template <class Epi> __device__ __forceinline__ void run_gemm(unsigned char* smem, const bf16_t* A, const bf16_t* Bt, int N, int K, const Epi& E, int cshift, int Mrows = MP) {
    pg8::Gemm g; g.A = A; g.Bt = Bt; g.M = Mrows; g.N = N; g.K = K;
    int G_ = gridDim.x; asm volatile("" : "+s"(G_));
    int c_ = blockIdx.x + cshift; if (c_ >= G_) c_ -= G_;
    pg8::StaticOrder S; S.init(Mrows, N, G_, c_);
    pg8::gemm_phase<Epi, pg8::StaticOrder, false>((PG8_LAS unsigned char*)smem, g, S, E, nullptr);
}


template <int MODE>
__device__ void skinny_meta(unsigned char* smem, const bf16_t* A, const bf16_t* Bt, int N, int K, void* out) {
    float* red = (float*)smem;
    const int tid = lt_tid(), wid = tid >> 6, lane = tid & 63, ln = lane & 15, g = lane >> 4;
    const int kw = K >> 3, k0 = wid * kw;
    const bf16_t* a0 = A + (size_t)(NMAIN + ln) * K + k0 + 8 * g;
    for (int grp = blockIdx.x; grp < (N >> 4); grp += gridDim.x) {
        const bf16_t* b0 = Bt + (size_t)(grp * 16 + ln) * K + k0 + 8 * g;
        f32x4 acc = {0.f, 0.f, 0.f, 0.f};
#pragma unroll 4
        for (int ks = 0; ks < (kw >> 5); ++ks) { const bf16x8 a = *(const bf16x8*)(a0 + 32 * ks), b = *(const bf16x8*)(b0 + 32 * ks); acc = MFMA16(a, b, acc); }
#pragma unroll
        for (int j = 0; j < 4; ++j) red[wid * 256 + (4 * g + j) * 16 + ln] = acc[j];
        __syncthreads();
        if (tid < 256) { float v = 0.f;
#pragma unroll
            for (int w = 0; w < 8; ++w) v += red[w * 256 + tid];
            const int r = tid >> 4, col = grp * 16 + (tid & 15);
#pragma unroll
            for (int b = 0; b < 4; ++b) { const size_t row = NMAIN + b * 16 + r;
                if (MODE == 0) ((float*)out)[row * DM + col] = v;
                else if (MODE == 1) { const float a = fmaxf(v, 0.f); ((bf16_t*)out)[row * DFF + col] = (bf16_t)(pk2(a * a, 0.f) & 0xffffu); }
                else ((bf16_t*)out)[row * DM + col] = (bf16_t)(pk2(v, 0.f) & 0xffffu); } }
        __syncthreads();
    }
}

__device__ __forceinline__ f32x4 wload4(int mode, const float* src, int k, int n) {
    const f32x4 z = {0.f, 0.f, 0.f, 0.f};
    if (mode == 0) {
        int c;
        if (n < 4608) c = n + (n >= 2560 ? 8 : 0) + (n >= 4096 ? 4 : 0);
        else if (n < 4608 + 8) c = 2560 + (n - 4608);
        else if (n < 4608 + 12) c = 4104;
        else return z;
        return __builtin_nontemporal_load((const f32x4*)(src + (size_t)k * 4620 + c));
    } else if (mode == 1) { return __builtin_nontemporal_load((const f32x4*)(src + (size_t)k * DM + n)); }
    else if (mode == 2) { return __builtin_nontemporal_load((const f32x4*)(src + (size_t)k * DFF + n)); }
    else if (mode == 3) { const int pn = n >> 8, i = n & 255; const int c = i < 128 ? pn * 128 + i : 512 + pn * 128 + (i - 128); return __builtin_nontemporal_load((const f32x4*)(src + (size_t)k * 1024 + c)); }
    else { const int g = n >> 7; return (k >> 7) == g ? __builtin_nontemporal_load((const f32x4*)(src + ((size_t)g * 128 + (k & 127)) * 128 + (n & 127))) : z; }
}
__device__ void convert_phase(const P& p, int l, unsigned char* smem) {
    float* tile = (float*)smem;
    const int tid = lt_tid();
    const int nt0 = (NIN / 64) * 8, nt1 = 32 * 8, nt2 = 128 * 8, nt3 = 32 * 32, nt4 = 16 * 2, nt5 = 8 * 2;
    const int total = nt0 + nt1 + nt2 + nt3 + nt4 + nt5;
    auto decode = [&](int tI, int& mode, int& K, const float*& src, bf16_t*& dst, int& k0, int& n0) {
        int x = tI;
        if (x < nt0) { mode = 0; K = 2048; src = p.in[I_WIN] + (size_t)l * DM * 4620; dst = (bf16_t*)(p.ws + OFF_WIN); }
        else if ((x -= nt0) < nt1) { mode = 1; K = 2048; src = p.in[I_WOUT] + (size_t)l * DM * DM; dst = (bf16_t*)(p.ws + OFF_WOUT); }
        else if ((x -= nt1) < nt2) { mode = 2; K = 2048; src = p.in[I_W1] + (size_t)l * DM * DFF; dst = (bf16_t*)(p.ws + OFF_W1); }
        else if ((x -= nt2) < nt3) { mode = 1; K = 8192; src = p.in[I_W2] + (size_t)l * DFF * DM; dst = (bf16_t*)(p.ws + OFF_W2); }
        else if ((x -= nt3) < nt4) { mode = 3; K = 512; src = p.in[I_GLUW] + (size_t)l * 512 * 1024; dst = (bf16_t*)(p.ws + OFF_WGLU); }
        else { x -= nt4; mode = 4; K = 512; src = p.in[I_POOLW] + (size_t)l * 4 * 128 * 128; dst = (bf16_t*)(p.ws + OFF_WPOOL); }
        const int ktiles = K / 256; k0 = (x % ktiles) * 256; n0 = (x / ktiles) * 64;
    };
    f32x4 v[8];
    int tI = blockIdx.x;
    if (tI < total) { int mode, K, k0, n0; const float* src; bf16_t* dst; decode(tI, mode, K, src, dst, k0, n0);
#pragma unroll
        for (int i = 0; i < 8; ++i) { const int e = tid + 512 * i, kk = e >> 4, n4 = (e & 15) * 4; v[i] = wload4(mode, src, k0 + kk, n0 + n4); } }
    for (; tI < total; tI += gridDim.x) {
        int mode, K, k0, n0; const float* src; bf16_t* dst; decode(tI, mode, K, src, dst, k0, n0);
#pragma unroll
        for (int i = 0; i < 8; ++i) { const int e = tid + 512 * i, kk = e >> 4, n4 = (e & 15) * 4;
#pragma unroll
            for (int j = 0; j < 4; ++j) tile[kk * 65 + ((n4 + j + (kk >> 3)) & 63)] = v[i][j]; }
        __syncthreads();
        if (tI + (int)gridDim.x < total) { int mode2, K2, k02, n02; const float* src2; bf16_t* dst2; decode(tI + gridDim.x, mode2, K2, src2, dst2, k02, n02);
#pragma unroll
            for (int i = 0; i < 8; ++i) { const int e = tid + 512 * i, kk = e >> 4, n4 = (e & 15) * 4; v[i] = wload4(mode2, src2, k02 + kk, n02 + n4); } }
#pragma unroll
        for (int i = 0; i < 4; ++i) { const int item = tid + 512 * i, kg = item & 31, nn = item >> 5; float w8[8];
#pragma unroll
            for (int jj = 0; jj < 8; ++jj) w8[jj] = tile[(kg * 8 + jj) * 65 + ((nn + kg) & 63)];
            u32x4 w; w.x = pk2(w8[0], w8[1]); w.y = pk2(w8[2], w8[3]); w.z = pk2(w8[4], w8[5]); w.w = pk2(w8[6], w8[7]);
            *(u32x4*)(dst + (size_t)(n0 + nn) * K + k0 + kg * 8) = w; }
        __syncthreads();
    }
}

__device__ __forceinline__ void store_norm_bf16(bf16_t* dstrow, const f32x4 (&v)[8], float rstd, const float* g, int lane) {
#pragma unroll
    for (int i = 0; i < 8; ++i) { const int c = 256 * i + 4 * lane; const f32x4 gg = *(const f32x4*)(g + c);
        uint2 w; w.x = pk2(v[i][0] * rstd * gg[0], v[i][1] * rstd * gg[1]); w.y = pk2(v[i][2] * rstd * gg[2], v[i][3] * rstd * gg[3]);
        *(uint2*)(dstrow + c) = w; }
}
__device__ __forceinline__ float sumsq(const f32x4 (&v)[8]) {
    float s = 0.f;
#pragma unroll
    for (int i = 0; i < 8; ++i) s += v[i][0] * v[i][0] + v[i][1] * v[i][1] + v[i][2] * v[i][2] + v[i][3] * v[i][3];
    return wsum(s);
}
__device__ __forceinline__ const float* in_row(const P& p, int r) { return r < NMAIN ? p.in[I_X] + (size_t)r * DM : p.in[I_META] + (size_t)((r - NMAIN) & 15) * DM; }
__device__ __forceinline__ void ld8x2(uint2 (&d)[8], const bf16_t* row, int lane) {
#pragma unroll
    for (int i = 0; i < 8; ++i) d[i] = *(const uint2*)(row + 256 * i + 4 * lane);
}
__device__ __forceinline__ void ld8x4(f32x4 (&d)[8], const float* row, int lane) {
#pragma unroll
    for (int i = 0; i < 8; ++i) d[i] = *(const f32x4*)(row + 256 * i + 4 * lane);
}
__device__ __forceinline__ f32x4 cvt4(uint2 w) { return (f32x4){__uint_as_float(w.x << 16), __uint_as_float(w.x & 0xffff0000u), __uint_as_float(w.y << 16), __uint_as_float(w.y & 0xffff0000u)}; }
__device__ void row_first(const P& p) {
    const int lane = lt_tid() & 63, gw = blockIdx.x * 8 + (lt_tid() >> 6), nw = gridDim.x * 8;
    bf16_t* abuf = (bf16_t*)(p.ws + OFF_ABUF);
    f32x4 q[8];
    if (gw < MR) ld8x4(q, in_row(p, gw), lane);
    for (int r = gw; r < MR; r += nw) {
        f32x4 v[8];
#pragma unroll
        for (int i = 0; i < 8; ++i) v[i] = q[i];
        if (r + nw < MR) ld8x4(q, in_row(p, r + nw), lane);
        const float rstd = rsqrtf(sumsq(v) * (1.f / DM) + EPS);
        store_norm_bf16(abuf + (size_t)r * DM, v, rstd, p.in[I_GPREMIX], lane);
    }
}
template <bool FIRST>
__device__ void row_postmix_t(const P& p, int l) {
    const int lane = lt_tid() & 63, gw = blockIdx.x * 8 + (lt_tid() >> 6), nw = gridDim.x * 8;
    bf16_t* abuf = (bf16_t*)(p.ws + OFF_ABUF); const bf16_t* mix = (const bf16_t*)(p.ws + OFF_FBUF);
    const float* gpm = p.in[I_GPOSTMIX] + l * DM; const float* gpf = p.in[I_GPREFFN] + l * DM;
    const int rend = (l == DEPTH - 1) ? NMAIN : MR;
    uint2 vq[8]; f32x4 hf[8]; uint2 hq[8];
    if (gw < rend) { ld8x2(vq, mix + (size_t)gw * DM, lane); if (FIRST) ld8x4(hf, in_row(p, gw), lane); else ld8x2(hq, hrow(p, gw), lane); }
    for (int r = gw; r < rend; r += nw) {
        f32x4 v[8], hc[8];
#pragma unroll
        for (int i = 0; i < 8; ++i) { v[i] = cvt4(vq[i]); hc[i] = FIRST ? hf[i] : cvt4(hq[i]); }
        const int rn = r + nw;
        if (rn < rend) { ld8x2(vq, mix + (size_t)rn * DM, lane); if (FIRST) ld8x4(hf, in_row(p, rn), lane); else ld8x2(hq, hrow(p, rn), lane); }
        bf16_t* hd = hrow(p, r);
        const float rm = rsqrtf(sumsq(v) * (1.f / DM) + EPS);
#pragma unroll
        for (int i = 0; i < 8; ++i) { const f32x4 gg = *(const f32x4*)(gpm + 256 * i + 4 * lane); hc[i] = hc[i] + v[i] * rm * gg; st4bf(hd + 256 * i + 4 * lane, hc[i]); }
        const float rh = rsqrtf(sumsq(hc) * (1.f / DM) + EPS);
        store_norm_bf16(abuf + (size_t)r * DM, hc, rh, gpf, lane);
    }
}
__device__ void row_postmix(const P& p, int l) { if (l == 0) row_postmix_t<true>(p, l); else row_postmix_t<false>(p, l); }
template <bool LAST>
__device__ void row_postffn_t(const P& p, int l) {
    const int lane = lt_tid() & 63, gw = blockIdx.x * 8 + (lt_tid() >> 6), nw = gridDim.x * 8;
    bf16_t* abuf = (bf16_t*)(p.ws + OFF_ABUF);
    const float* gpf = p.in[I_GPOSTFFN] + l * DM;
    const int rend = LAST ? NMAIN : MR;
    uint2 vq[8], hq[8];
    if (gw < rend) { ld8x2(vq, abuf + (size_t)gw * DM, lane); ld8x2(hq, hrow(p, gw), lane); }
    for (int r = gw; r < rend; r += nw) {
        f32x4 v[8], hc[8];
#pragma unroll
        for (int i = 0; i < 8; ++i) { v[i] = cvt4(vq[i]); hc[i] = cvt4(hq[i]); }
        const int rn = r + nw;
        if (rn < rend) { ld8x2(vq, abuf + (size_t)rn * DM, lane); ld8x2(hq, hrow(p, rn), lane); }
        bf16_t* hd = hrow(p, r);
        const float rm = rsqrtf(sumsq(v) * (1.f / DM) + EPS);
#pragma unroll
        for (int i = 0; i < 8; ++i) { const f32x4 gg = *(const f32x4*)(gpf + 256 * i + 4 * lane); hc[i] = hc[i] + v[i] * rm * gg;
            if (LAST) __builtin_nontemporal_store(hc[i], (f32x4*)(p.out + (size_t)r * DM + 256 * i + 4 * lane)); else st4bf(hd + 256 * i + 4 * lane, hc[i]); }
        if (!LAST) { const float rh = rsqrtf(sumsq(hc) * (1.f / DM) + EPS); store_norm_bf16(abuf + (size_t)r * DM, hc, rh, p.in[I_GPREMIX] + (l + 1) * DM, lane); }
    }
}
__device__ void row_postffn(const P& p, int l) { if (l == DEPTH - 1) row_postffn_t<true>(p, l); else row_postffn_t<false>(p, l); }

typedef float f32x2 __attribute__((ext_vector_type(2)));
struct S5Par { float ar, ai; f32x2 bb[16]; };
__device__ __forceinline__ void s5_params(const P& p, int l, int g, int pp, S5Par& q) {
    const int gi = l * 32 + g; const float lre = p.in[I_LRE][gi * 64 + pp], lim = p.in[I_LIM][gi * 64 + pp], dt = expf(p.in[I_LOGDT][gi]);
    const float er = expf(lre * dt); float sn, cs; sincosf(lim * dt, &sn, &cs); q.ar = er * cs; q.ai = er * sn;
    const float nr = q.ar - 1.f, ni = q.ai, den = 1.f / (lre * lre + lim * lim);
    const float cr = (nr * lre + ni * lim) * den, ci = (ni * lre - nr * lim) * den;
    const float* br = p.in[I_BRE] + ((size_t)gi * 64 + pp) * 16; const float* bi = p.in[I_BIM] + ((size_t)gi * 64 + pp) * 16;
#pragma unroll
    for (int h = 0; h < 16; ++h) { const float x = br[h], y = bi[h]; q.bb[h] = (f32x2){cr * x - ci * y, cr * y + ci * x}; }
}
__device__ __forceinline__ void s5_step(const S5Par& q, const float* ul, float& sr, float& si) {
    const f32x4 u0 = *(const f32x4*)ul, u1 = *(const f32x4*)(ul + 4), u2 = *(const f32x4*)(ul + 8), u3 = *(const f32x4*)(ul + 12);
    const float u[16] = {u0[0], u0[1], u0[2], u0[3], u1[0], u1[1], u1[2], u1[3], u2[0], u2[1], u2[2], u2[3], u3[0], u3[1], u3[2], u3[3]};
    f32x2 bu = {0.f, 0.f}, bv = {0.f, 0.f};
#pragma unroll
    for (int i = 0; i < 8; ++i) { bu = __builtin_elementwise_fma((f32x2){u[2 * i], u[2 * i]}, q.bb[2 * i], bu); bv = __builtin_elementwise_fma((f32x2){u[2 * i + 1], u[2 * i + 1]}, q.bb[2 * i + 1], bv); }
    bu = bu + bv;
    f32x2 t = __builtin_elementwise_fma((f32x2){q.ai, q.ai}, (f32x2){-si, sr}, bu);
    t = __builtin_elementwise_fma((f32x2){q.ar, q.ar}, (f32x2){sr, si}, t);
    sr = t.x; si = t.y;
}
__device__ __forceinline__ void s5_put(float* dst, const int (&ur)[8]) {
#pragma unroll
    for (int i = 0; i < 4; ++i) { const unsigned a = (unsigned)ur[2 * i], b = (unsigned)ur[2 * i + 1];
        *(f32x4*)(dst + 4 * i) = (f32x4){__uint_as_float(a << 16), __uint_as_float(a & 0xffff0000u), __uint_as_float(b << 16), __uint_as_float(b & 0xffff0000u)}; }
}
#define S5_LOADU(ur, up, tg, nt, lane) do { const int tt_ = min((tg) + (lane), (nt) - 1); const uint4 a_ = *(const uint4*)((up) + (size_t)tt_ * NPROJ), b_ = *(const uint4*)((up) + (size_t)tt_ * NPROJ + 8); \
        ur[0] = a_.x; ur[1] = a_.y; ur[2] = a_.z; ur[3] = a_.w; ur[4] = b_.x; ur[5] = b_.y; ur[6] = b_.z; ur[7] = b_.w; } while (0)
#define S5_BCAST(w, ur, tl) do { w[0] = __builtin_amdgcn_readlane(ur[0], tl); w[1] = __builtin_amdgcn_readlane(ur[1], tl); w[2] = __builtin_amdgcn_readlane(ur[2], tl); w[3] = __builtin_amdgcn_readlane(ur[3], tl); \
        w[4] = __builtin_amdgcn_readlane(ur[4], tl); w[5] = __builtin_amdgcn_readlane(ur[5], tl); w[6] = __builtin_amdgcn_readlane(ur[6], tl); w[7] = __builtin_amdgcn_readlane(ur[7], tl); } while (0)
__device__ void s5_pass1(const P& p, int l, int jb, unsigned char* smem) {
    const int tid = lt_tid(), wid = __builtin_amdgcn_readfirstlane(tid >> 6), lane = tid & 63;
    const int b = jb / 132, rem = jb % 132, c = rem >> 2, g = (rem & 3) * 8 + wid;
    float* Uf = (float*)smem + wid * (64 * 16);
    S5Par q; s5_params(p, l, g, lane, q);
    const int t0 = c == 0 ? 0 : 128 * c - 112, nt = c == 0 ? 16 : 128;
    const bf16_t* up = (const bf16_t*)(p.ws + OFF_PROJ) + (size_t)rmap(b, t0) * NPROJ + C_S5U + g * 16;
    float sr = 0.f, si = 0.f;
    int ur[8], un[8];
    S5_LOADU(ur, up, 0, nt, lane);
    for (int tg = 0; tg < nt; tg += 64) {
        s5_put(Uf + lane * 16, ur);
        if (tg + 64 < nt) S5_LOADU(un, up, tg + 64, nt, lane);
        __builtin_amdgcn_wave_barrier();
        const int cnt = min(64, nt - tg);
#pragma unroll 4
        for (int tl = 0; tl < cnt; ++tl) s5_step(q, Uf + tl * 16, sr, si);
        __builtin_amdgcn_wave_barrier();
#pragma unroll
        for (int k = 0; k < 8; ++k) ur[k] = un[k];
    }
    ((float2*)(p.ws + OFF_S5E))[(size_t)(b * NCH + c) * 2048 + g * 64 + lane] = make_float2(sr, si);
}
__device__ void s5_carry(const P& p, int l, int jb) {
    const int id = jb * 512 + lt_tid(), b = id >> 11, gp = id & 2047, gi = l * 32 + (gp >> 6);
    const float lre = p.in[I_LRE][gi * 64 + (gp & 63)], lim = p.in[I_LIM][gi * 64 + (gp & 63)], dt = expf(p.in[I_LOGDT][gi]);
    const float er = expf(128.f * lre * dt); float sn, cs; sincosf(128.f * lim * dt, &sn, &cs); const float ar = er * cs, ai = er * sn;
    const float2* E = (const float2*)(p.ws + OFF_S5E); float2* SI = (float2*)(p.ws + OFF_S5IN);
    float sr = 0.f; asm volatile("" : "+v"(sr)); float si = sr;
    for (int c0 = 0; c0 < NCH; c0 += 11) { float2 eb[11];
#pragma unroll
        for (int i = 0; i < 11; ++i) eb[i] = E[(size_t)(b * NCH + c0 + i) * 2048 + gp];
#pragma unroll
        for (int i = 0; i < 11; ++i) { SI[(size_t)(b * NCH + c0 + i) * 2048 + gp] = make_float2(sr, si);
            const float nsr = ar * sr - ai * si + eb[i].x, nsi = ar * si + ai * sr + eb[i].y; sr = nsr; si = nsi; } }
}
__device__ __forceinline__ float gelu_tanh(float y) { const float z = 0.7978845608028654f * (y + 0.044715f * y * y * y); const float th = 1.f - 2.f / (__expf(2.f * z) + 1.f); return 0.5f * y * (1.f + th); }
__device__ void s5_pass2(const P& p, int l, int jb, unsigned char* smem) {
    const int wid = __builtin_amdgcn_readfirstlane(lt_tid() >> 6), lane = lt_tid() & 63, ln = lane & 15, g4 = lane >> 4;
    const int b = jb / 132, rem = jb % 132, c = rem >> 2, g = (rem & 3) * 8 + wid, gi = l * 32 + g;
    unsigned char* wbase = smem + wid * (4352 + 4096 + 4096);
    bf16_t* Xs = (bf16_t*)wbase; float* Uf = (float*)(wbase + 4352); bf16_t* Ys = (bf16_t*)(wbase + 4352 + 4096);
    S5Par q; s5_params(p, l, g, lane, q);
    bf16x8 cf[4];
#pragma unroll
    for (int ks = 0; ks < 4; ++ks) { const int pp = 16 * ks + 4 * g4;
        const f32x4 cr = *(const f32x4*)(p.in[I_CRE] + ((size_t)gi * 16 + ln) * 64 + pp), ci = *(const f32x4*)(p.in[I_CIM] + ((size_t)gi * 16 + ln) * 64 + pp);
        u32x4 w; w.x = pk2(cr[0], -ci[0]); w.y = pk2(cr[1], -ci[1]); w.z = pk2(cr[2], -ci[2]); w.w = pk2(cr[3], -ci[3]); cf[ks] = *(bf16x8*)&w; }
    const float dv = p.in[I_SD][gi * 16 + ln];
    const int t0 = c == 0 ? 0 : 128 * c - 112, nt = c == 0 ? 16 : 128;
    const bf16_t* up = (const bf16_t*)(p.ws + OFF_PROJ) + (size_t)rmap(b, t0) * NPROJ + C_S5U + g * 16;
    bf16_t* sy = (bf16_t*)(p.ws + OFF_SY) + (size_t)rmap(b, t0) * 512 + g * 16;
    const float2 s0 = ((const float2*)(p.ws + OFF_S5IN))[(size_t)(b * NCH + c) * 2048 + g * 64 + lane];
    float sr = s0.x, si = s0.y;
    int ur[8], un[8];
    S5_LOADU(ur, up, 0, nt, lane);
    for (int tg0 = 0; tg0 < nt; tg0 += 64) {
        s5_put(Uf + lane * 16, ur);
        if (tg0 + 64 < nt) S5_LOADU(un, up, tg0 + 64, nt, lane);
        __builtin_amdgcn_wave_barrier();
        const int cnt = min(64, nt - tg0);
        for (int sub = 0; sub < cnt; sub += 16) {
            const int tg = tg0 + sub;
#pragma unroll 4
            for (int tl = 0; tl < 16; ++tl) { s5_step(q, Uf + (sub + tl) * 16, sr, si); *(unsigned*)(Xs + tl * 136 + 2 * lane) = pk2(sr, si); }
            __builtin_amdgcn_wave_barrier();
            f32x4 acc = {0.f, 0.f, 0.f, 0.f};
#pragma unroll
            for (int ks = 0; ks < 4; ++ks) { const bf16x8 a = *(const bf16x8*)(Xs + ln * 136 + 32 * ks + 8 * g4); acc = MFMA16(a, cf[ks], acc); }
#pragma unroll
            for (int j = 0; j < 4; ++j) { const float u = Uf[(sub + 4 * g4 + j) * 16 + ln];
                const float y = gelu_tanh(acc[j] + dv * u); Ys[(tg + 4 * g4 + j) * 16 + ln] = (bf16_t)(pk2(y, 0.f) & 0xffffu); }
            __builtin_amdgcn_wave_barrier();
        }
#pragma unroll
        for (int k = 0; k < 8; ++k) ur[k] = un[k];
    }
    __builtin_amdgcn_wave_barrier();
#pragma unroll
    for (int hh = 0; hh < 2; ++hh) { const int tk = lane + 64 * hh;
        if (tk < nt) { const uint4 y0 = *(const uint4*)(Ys + tk * 16), y1 = *(const uint4*)(Ys + tk * 16 + 8); *(uint4*)(sy + (size_t)tk * 512) = y0; *(uint4*)(sy + (size_t)tk * 512 + 8) = y1; } }
    __builtin_amdgcn_wave_barrier();
}

__device__ void pool_pre(const P& p, int jb) {
    const bf16_t* proj = (const bf16_t*)(p.ws + OFF_PROJ); bf16_t* pooled = (bf16_t*)(p.ws + OFF_POOLED);
    const int tid = lt_tid(), cg8 = tid & 63, c = cg8 * 8, w = 2 << (c >> 7);
    const int r0 = jb * 32 + (tid >> 6) * 4; if (r0 >= MR) return;
    const int b = r0 < NMAIN ? (r0 >> 12) : ((r0 - NMAIN) >> 4), t0 = r0 < NMAIN ? (r0 & 4095) + 16 : ((r0 - NMAIN) & 15);
    uint4 xs[19];
#pragma unroll
    for (int i = 0; i < 19; ++i) { const int tt = t0 - 15 + i; xs[i] = make_uint4(0, 0, 0, 0); if (tt >= 0 && i >= 16 - w) xs[i] = *(const uint4*)(proj + (size_t)rmap(b, tt) * NPROJ + C_PLU + c); }
    float sacc[4][8], self[4][8];
#pragma unroll
    for (int q = 0; q < 4; ++q)
#pragma unroll
        for (int k = 0; k < 8; ++k) { sacc[q][k] = 0.f; self[q][k] = 0.f; }
#pragma unroll
    for (int i = 0; i < 19; ++i) { const unsigned xw[4] = {xs[i].x, xs[i].y, xs[i].z, xs[i].w}; float f[8];
#pragma unroll
        for (int k = 0; k < 4; ++k) { f[2 * k] = __uint_as_float(xw[k] << 16); f[2 * k + 1] = __uint_as_float(xw[k] & 0xffff0000u); }
#pragma unroll
        for (int q = 0; q < 4; ++q) {
            if (i <= 15 + q) { const bool in = i >= 16 + q - w;
#pragma unroll
                for (int k = 0; k < 8; ++k) sacc[q][k] += in ? f[k] : 0.f; }
            if (i == 15 + q) {
#pragma unroll
                for (int k = 0; k < 8; ++k) self[q][k] = f[k]; } } }
#pragma unroll
    for (int q = 0; q < 4; ++q) { const int t = t0 + q, cnt = min(t + 1, w); const float inv = 1.f / (float)cnt;
        u32x4 o; o.x = pk2(sacc[q][0] * inv - self[q][0], sacc[q][1] * inv - self[q][1]); o.y = pk2(sacc[q][2] * inv - self[q][2], sacc[q][3] * inv - self[q][3]);
        o.z = pk2(sacc[q][4] * inv - self[q][4], sacc[q][5] * inv - self[q][5]); o.w = pk2(sacc[q][6] * inv - self[q][6], sacc[q][7] * inv - self[q][7]);
        *(u32x4*)(pooled + (size_t)(r0 + q) * 512 + c) = o; }
}
__device__ void fox_cum(const P& p, int l, int bh, unsigned char* smem) {
    float* sw = (float*)smem;
    const int tid = lt_tid(), lane = tid & 63, wid = tid >> 6, b = bh >> 2, h = bh & 3; const float bias = p.in[I_FXGB][l * 4 + h];
    const float* gates = (const float*)(p.ws + OFF_GATES); float* cum = (float*)(p.ws + OFF_CUM) + bh * LPF;
    if (tid < 112) cum[tid] = 0.f;
    const int ta = tid * 9; float v[9], s = 0.f;
#pragma unroll
    for (int i = 0; i < 9; ++i) { const int t = ta + i; v[i] = t < LT ? gates[(size_t)rmap(b, t) * 16 + 8 + h] : 0.f; }
#pragma unroll
    for (int i = 0; i < 9; ++i) { const int t = ta + i; s += t < LT ? logsig(v[i] + bias) : 0.f; v[i] = s; }
    float inc = s;
    for (int o = 1; o < 64; o <<= 1) { const float n = __shfl_up(inc, o); if (lane >= o) inc += n; }
    if (lane == 63) sw[wid] = inc;
    __syncthreads();
    float base = inc - s;
    for (int w = 0; w < wid; ++w) base += sw[w];
#pragma unroll
    for (int i = 0; i < 9; ++i) { const int t = ta + i; if (t < LT) cum[112 + t] = base + v[i]; }
    __syncthreads();
}

__device__ void ml_pass1(const P& p, int l, int j, unsigned char* smem) {
    const int tid = lt_tid(), wid = __builtin_amdgcn_readfirstlane(tid >> 6), lane = tid & 63, ln = lane & 15, g = lane >> 4, q4 = (lane >> 2) & 3, p4 = lane & 3;
    const int bh = j / NCH, c = j % NCH, b = bh >> 2, h = bh & 3, t0 = 128 * c - 112;
    bf16_t* Vs = (bf16_t*)smem;
    bf16_t* Kw = Vs + 128 * 144;
    float* fw = (float*)(Kw + 128 * 144);
    float* fx = fw + 128;
    float* fpart = fx + 8;
    const bf16_t* proj = (const bf16_t*)(p.ws + OFF_PROJ); const float* gates = (const float*)(p.ws + OFF_GATES);
    float lf = 0.f, li = NEGB, bs = 0.f;
    if (tid < 128) { const int t = t0 + tid;
        if (t >= 0) { const float* gp = gates + (size_t)rmap(b, t) * 16; li = gp[h] + p.in[I_MLGB][l * 8 + h]; lf = logsig(gp[4 + h] + p.in[I_MLGB][l * 8 + 4 + h]); }
        bs = lf;
        for (int o = 1; o < 64; o <<= 1) { const float n = __shfl_up(bs, o); if (lane >= o) bs += n; }
        if (tid == 63) fx[0] = bs; }
    __syncthreads();
    if (tid >= 64 && tid < 128) bs += fx[0];
    if (tid == 127) fx[1] = bs;
    __syncthreads();
    const float gtot = fx[1];
    float as = NEGB;
    if (tid < 128) { as = gtot - bs + li; const float mw = wmaxf(as); if (lane == 0) fx[2 + wid] = mw; }
    __syncthreads();
    const float mloc = fmaxf(fx[2], fx[3]);
    if (tid < 128) { fw[tid] = expf(as - mloc);
        ((float*)(p.ws + OFF_BCUM))[bh * LPF + 128 * c + tid] = bs; ((float*)(p.ws + OFF_MLI))[bh * LPF + 128 * c + tid] = li;
        if (tid == 0) { ((float*)(p.ws + OFF_MLG))[j] = gtot; ((float*)(p.ws + OFF_MLM))[j] = mloc; } }
    __syncthreads();
    const float* cw = p.in[I_CONVW] + (size_t)l * 4 * 1024;
    bf16_t* qc = (bf16_t*)(p.ws + OFF_QC); bf16_t* kc = (bf16_t*)(p.ws + OFF_KC);
#pragma unroll 4
    for (int it = 0; it < 8; ++it) {
        const int id = tid + 512 * (it & 3), s = id >> 4, dg = id & 15, isk = it >> 2, t = t0 + s;
        const int ch = h * 128 + dg * 8;
        float a[8] = {0, 0, 0, 0, 0, 0, 0, 0};
        if (t >= 0) {
            uint4 xt[4];
#pragma unroll
            for (int jj = 0; jj < 4; ++jj) { const int tt = t - 3 + jj; xt[jj] = make_uint4(0, 0, 0, 0); if (tt >= 0) xt[jj] = *(const uint4*)(proj + (size_t)rmap(b, tt) * NPROJ + (isk ? C_MLK : C_MLQ) + ch); }
#pragma unroll
            for (int jj = 0; jj < 4; ++jj) { const unsigned xw[4] = {xt[jj].x, xt[jj].y, xt[jj].z, xt[jj].w};
                const float* wp = cw + jj * 1024 + isk * 512 + ch; const f32x4 w0 = *(const f32x4*)wp, w1 = *(const f32x4*)(wp + 4);
                const float wv[8] = {w0[0], w0[1], w0[2], w0[3], w1[0], w1[1], w1[2], w1[3]};
#pragma unroll
                for (int i = 0; i < 4; ++i) { a[2 * i] = fmaf(__uint_as_float(xw[i] << 16), wv[2 * i], a[2 * i]); a[2 * i + 1] = fmaf(__uint_as_float(xw[i] & 0xffff0000u), wv[2 * i + 1], a[2 * i + 1]); } }
#pragma unroll
            for (int i = 0; i < 8; ++i) a[i] = a[i] / (1.f + __expf(-a[i]));
        }
        if (!isk) { if (t >= 0) { u32x4 o; o.x = pk2(a[0], a[1]); o.y = pk2(a[2], a[3]); o.z = pk2(a[4], a[5]); o.w = pk2(a[6], a[7]); *(u32x4*)(qc + (size_t)rmap(b, t) * 512 + ch) = o; } }
        else {
#pragma unroll
            for (int i = 0; i < 8; ++i) a[i] *= 0.08838834764831845f;
            if (t >= 0) { u32x4 o; o.x = pk2(a[0], a[1]); o.y = pk2(a[2], a[3]); o.z = pk2(a[4], a[5]); o.w = pk2(a[6], a[7]); *(u32x4*)(kc + (size_t)rmap(b, t) * 512 + ch) = o; }
            const float ws = t >= 0 ? fw[s] : 0.f;
            u32x4 o; o.x = pk2(a[0] * ws, a[1] * ws); o.y = pk2(a[2] * ws, a[3] * ws); o.z = pk2(a[4] * ws, a[5] * ws); o.w = pk2(a[6] * ws, a[7] * ws);
            *(u32x4*)(Kw + s * 144 + dg * 8) = o;
            uint4 vv = make_uint4(0, 0, 0, 0); if (t >= 0) vv = *(const uint4*)(proj + (size_t)rmap(b, t) * NPROJ + C_MLV + ch);
            *(uint4*)(Vs + s * 144 + dg * 8) = vv;
        }
    }
    __syncthreads();
    f32x4 acc[8];
#pragma unroll
    for (int nt = 0; nt < 8; ++nt) acc[nt] = (f32x4){0.f, 0.f, 0.f, 0.f};
#pragma unroll
    for (int ks = 0; ks < 4; ++ks) {
        const int r0 = 32 * ks + 8 * g + q4;
        const bf16x8 af = cat8(trrd(Vs + r0 * 144 + 16 * wid + 4 * p4), trrd(Vs + (r0 + 4) * 144 + 16 * wid + 4 * p4));
#pragma unroll
        for (int nt = 0; nt < 8; ++nt) { const bf16x8 bfr = cat8(trrd(Kw + r0 * 144 + 16 * nt + 4 * p4), trrd(Kw + (r0 + 4) * 144 + 16 * nt + 4 * p4)); acc[nt] = MFMA16(af, bfr, acc[nt]); }
    }
    float* cl = (float*)(p.ws + OFF_CLOC) + (size_t)j * 16384;
#pragma unroll
    for (int nt = 0; nt < 8; ++nt)
#pragma unroll
        for (int jj = 0; jj < 4; ++jj) cl[(16 * wid + 4 * g + jj) * 128 + 16 * nt + ln] = acc[nt][jj];
    { const int kk = tid & 127, part = tid >> 7; float s = 0.f;
#pragma unroll 8
      for (int ss = 0; ss < 32; ++ss) s += bf2f(Kw[(part * 32 + ss) * 144 + kk]);
      fpart[part * 128 + kk] = s; }
    __syncthreads();
    if (tid < 128) ((float*)(p.ws + OFF_NLOC))[j * 128 + tid] = fpart[tid] + fpart[128 + tid] + fpart[256 + tid] + fpart[384 + tid];
    __syncthreads();
}
__device__ void ml_scan(const P& p, int jb) {
    const int bh = jb >> 3, part = jb & 7, tid = lt_tid();
    float* cl = (float*)(p.ws + OFF_CLOC); float* nl = (float*)(p.ws + OFF_NLOC);
    const float* G = (const float*)(p.ws + OFF_MLG); const float* ML = (const float*)(p.ws + OFF_MLM); float* MS = (float*)(p.ws + OFF_MST);
    f32x4 C = {0.f, 0.f, 0.f, 0.f}; float n = 0.f, m = 0.f;
    const bool don = (part == 0 && tid < 128);
    for (int c0 = 0; c0 < NCH; c0 += 11) {
        f32x4 xb[11]; float gb[11], mlb[11], nxb[11];
#pragma unroll
        for (int i = 0; i < 11; ++i) { const int j = bh * NCH + c0 + i;
            xb[i] = *(const f32x4*)(cl + (size_t)j * 16384 + part * 2048 + tid * 4); gb[i] = G[j]; mlb[i] = ML[j]; nxb[i] = don ? nl[j * 128 + tid] : 0.f; }
#pragma unroll
        for (int i = 0; i < 11; ++i) { const int j = bh * NCH + c0 + i;
            *(f32x4*)(cl + (size_t)j * 16384 + part * 2048 + tid * 4) = C;
            if (don) nl[j * 128 + tid] = n;
            if (part == 0 && tid == 0) MS[j] = m;
            const float mn = fmaxf(gb[i] + m, mlb[i]), dec = expf(gb[i] + m - mn), sc = expf(mlb[i] - mn);
            C = C * dec + xb[i] * sc; n = n * dec + nxb[i] * sc; m = mn; }
    }
}
__device__ void ml_pass2(const P& p, int l, int j, unsigned char* smem) {
    const int tid = lt_tid(), wid = __builtin_amdgcn_readfirstlane(tid >> 6), lane = tid & 63, ln = lane & 15, g = lane >> 4, q4 = (lane >> 2) & 3, p4 = lane & 3;
    const int bh = j / NCH, c = j % NCH, b = bh >> 2, h = bh & 3, t0 = 128 * c - 112;
    bf16_t* Ks = (bf16_t*)smem;
    bf16_t* Cs = Ks + 128 * 136;
    bf16_t* Vs = Cs + 128 * 136;
    float* fb = (float*)(Vs + 128 * 144); float* fli = fb + 128; float* fn = fli + 128;
    const bf16_t* proj = (const bf16_t*)(p.ws + OFF_PROJ);
    const bf16_t* qc = (const bf16_t*)(p.ws + OFF_QC); const bf16_t* kc = (const bf16_t*)(p.ws + OFF_KC);
    const float* cst = (const float*)(p.ws + OFF_CLOC) + (size_t)j * 16384;
#pragma unroll
    for (int it = 0; it < 4; ++it) { const int id = tid + 512 * it, s = id >> 4, dg = id & 15, t = t0 + s;
        uint4 kk = make_uint4(0, 0, 0, 0), vv = kk;
        if (t >= 0) { kk = *(const uint4*)(kc + (size_t)rmap(b, t) * 512 + h * 128 + dg * 8); vv = *(const uint4*)(proj + (size_t)rmap(b, t) * NPROJ + C_MLV + h * 128 + dg * 8); }
        *(uint4*)(Ks + s * 136 + dg * 8) = kk; *(uint4*)(Vs + s * 144 + dg * 8) = vv;
        const f32x4 c0 = *(const f32x4*)(cst + s * 128 + dg * 8), c1 = *(const f32x4*)(cst + s * 128 + dg * 8 + 4);
        u32x4 o; o.x = pk2(c0[0], c0[1]); o.y = pk2(c0[2], c0[3]); o.z = pk2(c1[0], c1[1]); o.w = pk2(c1[2], c1[3]); *(u32x4*)(Cs + s * 136 + dg * 8) = o; }
    if (tid < 128) { fb[tid] = ((const float*)(p.ws + OFF_BCUM))[bh * LPF + 128 * c + tid]; fli[tid] = ((const float*)(p.ws + OFF_MLI))[bh * LPF + 128 * c + tid]; fn[tid] = ((const float*)(p.ws + OFF_NLOC))[j * 128 + tid]; }
    const float mst = ((const float*)(p.ws + OFF_MST))[j];
    __syncthreads();
    const int tl = 16 * wid + ln, tq = t0 + tl;
    if (t0 + 16 * wid >= 0) {
        const size_t r = (size_t)rmap(b, tq);
        bf16x8 qf[4];
#pragma unroll
        for (int ks = 0; ks < 4; ++ks) qf[ks] = *(const bf16x8*)(qc + r * 512 + h * 128 + 32 * ks + 8 * g);
        const float bt = fb[tl];
        f32x4 sc[8]; float mx = NEGB;
#pragma unroll
        for (int mt = 0; mt < 8; ++mt) { sc[mt] = (f32x4){0.f, 0.f, 0.f, 0.f};
            if (mt <= wid) {
#pragma unroll
                for (int ks = 0; ks < 4; ++ks) { const bf16x8 a = *(const bf16x8*)(Ks + (16 * mt + ln) * 136 + 32 * ks + 8 * g); sc[mt] = MFMA16(a, qf[ks], sc[mt]); }
            } }
#pragma unroll
        for (int mt = 0; mt < 8; ++mt) {
            if (mt <= wid) { const f32x4 bsv = *(const f32x4*)(fb + 16 * mt + 4 * g), liv = *(const f32x4*)(fli + 16 * mt + 4 * g);
#pragma unroll
                for (int jj = 0; jj < 4; ++jj) { const int s = 16 * mt + 4 * g + jj; const float d = (s <= tl) ? (bt - bsv[jj] + liv[jj]) : NEGB; mx = fmaxf(mx, d); } } }
        mx = fmaxf(mx, __shfl_xor(mx, 16)); mx = fmaxf(mx, __shfl_xor(mx, 32));
        const float minter = bt + mst, mcomb = fmaxf(minter, mx), iw = __builtin_amdgcn_exp2f((minter - mcomb) * LOG2E);
        float dsum = 0.f;
#pragma unroll
        for (int mt = 0; mt < 8; ++mt) {
            if (mt <= wid) { const f32x4 bsv = *(const f32x4*)(fb + 16 * mt + 4 * g), liv = *(const f32x4*)(fli + 16 * mt + 4 * g);
#pragma unroll
                for (int jj = 0; jj < 4; ++jj) { const int s = 16 * mt + 4 * g + jj; const float d = (s <= tl) ? (bt - bsv[jj] + liv[jj]) : NEGB;
                    const float w = sc[mt][jj] * __builtin_amdgcn_exp2f((d - mcomb) * LOG2E); sc[mt][jj] = w; dsum += w; } } }
        f32x4 acc[8];
#pragma unroll
        for (int vt = 0; vt < 8; ++vt) { acc[vt] = (f32x4){0.f, 0.f, 0.f, 0.f};
#pragma unroll
            for (int ks = 0; ks < 4; ++ks) { const bf16x8 a = *(const bf16x8*)(Cs + (16 * vt + ln) * 136 + 32 * ks + 8 * g); acc[vt] = MFMA16(a, qf[ks], acc[vt]); }
            acc[vt] = acc[vt] * iw; }
        float qn = 0.f;
#pragma unroll
        for (int ks = 0; ks < 4; ++ks)
#pragma unroll
            for (int i = 0; i < 8; ++i) qn = fmaf(bf2f((unsigned short)qf[ks][i]), fn[32 * ks + 8 * g + i], qn);
#pragma unroll
        for (int a = 0; a < 4; ++a) {
            if (2 * a <= wid) {
                u32x4 w; w.x = pk2(sc[2 * a][0], sc[2 * a][1]); w.y = pk2(sc[2 * a][2], sc[2 * a][3]); w.z = pk2(sc[2 * a + 1][0], sc[2 * a + 1][1]); w.w = pk2(sc[2 * a + 1][2], sc[2 * a + 1][3]);
                const bf16x8 pb = *(bf16x8*)&w;
                const int r0 = 32 * a + 4 * g + q4;
#pragma unroll
                for (int vt = 0; vt < 8; ++vt) { const bf16x8 af = cat8(trrd(Vs + r0 * 144 + 16 * vt + 4 * p4), trrd(Vs + (r0 + 16) * 144 + 16 * vt + 4 * p4)); acc[vt] = MFMA16(af, pb, acc[vt]); }
            } }
        dsum += __shfl_xor(dsum, 16); dsum += __shfl_xor(dsum, 32); qn += __shfl_xor(qn, 16); qn += __shfl_xor(qn, 32);
        const float den = dsum + iw * qn, dnm = 1.f / fmaxf(fabsf(den), expf(-mcomb));
        float ss = 0.f;
#pragma unroll
        for (int vt = 0; vt < 8; ++vt) { acc[vt] = acc[vt] * dnm; ss += acc[vt][0] * acc[vt][0] + acc[vt][1] * acc[vt][1] + acc[vt][2] * acc[vt][2] + acc[vt][3] * acc[vt][3]; }
        ss += __shfl_xor(ss, 16); ss += __shfl_xor(ss, 32);
        const float rs = rsqrtf(ss * (1.f / 128.f) + EPS);
        bf16_t* yo = (bf16_t*)(p.ws + OFF_ABUF) + r * DM + 512 + h * 128;
        const float* ng = p.in[I_NORMG] + l * 512 + h * 128;
#pragma unroll
        for (int vt = 0; vt < 8; ++vt) { const int v0 = 16 * vt + 4 * g; const f32x4 gg = *(const f32x4*)(ng + v0);
            const uint2 ow = *(const uint2*)(proj + r * NPROJ + C_MLO + h * 128 + v0);
            const float o0 = sigm(__uint_as_float(ow.x << 16)), o1 = sigm(__uint_as_float(ow.x & 0xffff0000u)), o2 = sigm(__uint_as_float(ow.y << 16)), o3 = sigm(__uint_as_float(ow.y & 0xffff0000u));
            uint2 w; w.x = pk2(acc[vt][0] * rs * gg[0] * o0, acc[vt][1] * rs * gg[1] * o1); w.y = pk2(acc[vt][2] * rs * gg[2] * o2, acc[vt][3] * rs * gg[3] * o3);
            *(uint2*)(yo + v0) = w; }
    }
    __syncthreads();
}

__device__ __forceinline__ void fox_softmax(f32x4 (&sc)[4], f32x4 (&acc)[8], float& m, float& ls, bf16x8 (&pb)[2], const float* ckb, float ct, int tq, int kbase_t, bool domask, int g) {
    constexpr float C2 = 0.08838834764831845f * LOG2E;
    float mx = -__builtin_inff();
    if (domask) {
#pragma unroll
        for (int mt = 0; mt < 4; ++mt) { const f32x4 cv = *(const f32x4*)(ckb + 16 * mt + 4 * g);
#pragma unroll
            for (int jj = 0; jj < 4; ++jj) { float v = fmaf(sc[mt][jj], C2, cv[jj]);
                const int kt_t = kbase_t + 16 * mt + 4 * g + jj; if (kt_t < 0 || kt_t > tq) v = -__builtin_inff();
                sc[mt][jj] = v; mx = fmaxf(mx, v); } }
    } else {
#pragma unroll
        for (int mt = 0; mt < 4; ++mt) { const f32x4 cv = *(const f32x4*)(ckb + 16 * mt + 4 * g);
#pragma unroll
            for (int jj = 0; jj < 4; ++jj) { const float v = fmaf(sc[mt][jj], C2, cv[jj]); sc[mt][jj] = v; mx = fmaxf(mx, v); } }
    }
    mx = fmaxf(mx, __shfl_xor(mx, 16)); mx = fmaxf(mx, __shfl_xor(mx, 32));
    const bool keep = __all(mx - m <= 8.f);
    float mn = m;
    if (!keep) { mn = fmaxf(m, mx); const float alpha = __builtin_amdgcn_exp2f(m - mn); m = mn; ls *= alpha;
#pragma unroll
        for (int vt = 0; vt < 8; ++vt) acc[vt] = acc[vt] * alpha; }
    float ps = 0.f;
#pragma unroll
    for (int mt = 0; mt < 4; ++mt)
#pragma unroll
        for (int jj = 0; jj < 4; ++jj) { const float e = __builtin_amdgcn_exp2f(sc[mt][jj] - mn); sc[mt][jj] = e; ps += e; }
    ls += ps;
#pragma unroll
    for (int a = 0; a < 2; ++a) { u32x4 w; w.x = pk2(sc[2 * a][0], sc[2 * a][1]); w.y = pk2(sc[2 * a][2], sc[2 * a][3]); w.z = pk2(sc[2 * a + 1][0], sc[2 * a + 1][1]); w.w = pk2(sc[2 * a + 1][2], sc[2 * a + 1][3]); pb[a] = *(bf16x8*)&w; }
}
template <bool BOTH>
__device__ __forceinline__ void fox_tile(const bf16_t* Ks, const bf16_t* Vs, int rb, const bf16x8 (&qf0)[4], const bf16x8 (&qf1)[4], f32x4 (&acc0)[8], f32x4 (&acc1)[8],
                                         float& m0, float& m1, float& ls0, float& ls1, const float* ckb, float ct0, float ct1, int tq0, int tq1, int kbase_t, bool mask0, bool mask1,
                                         int ln, int g, int q4, int p4) {
    f32x4 sc0[4], sc1[4];
    __builtin_amdgcn_s_setprio(1);
#pragma unroll
    for (int mt = 0; mt < 4; ++mt) { sc0[mt] = (f32x4){0.f, 0.f, 0.f, 0.f}; sc1[mt] = (f32x4){0.f, 0.f, 0.f, 0.f};
#pragma unroll
        for (int ks = 0; ks < 4; ++ks) { const bf16x8 a = *(const bf16x8*)(Ks + (rb + 16 * mt + ln) * 136 + 32 * ks + 8 * g);
            sc1[mt] = MFMA16(a, qf1[ks], sc1[mt]); if (BOTH) sc0[mt] = MFMA16(a, qf0[ks], sc0[mt]); } }
    __builtin_amdgcn_s_setprio(0);
    bf16x8 pb0[2], pb1[2];
    fox_softmax(sc1, acc1, m1, ls1, pb1, ckb, ct1, tq1, kbase_t, mask1, g);
    if (BOTH) fox_softmax(sc0, acc0, m0, ls0, pb0, ckb, ct0, tq0, kbase_t, mask0, g);
    __builtin_amdgcn_s_setprio(1);
#pragma unroll
    for (int a = 0; a < 2; ++a) {
        const int r0v = rb + 32 * a + 4 * g + q4;
#pragma unroll
        for (int vt = 0; vt < 8; ++vt) { const bf16x8 af = cat8(trrd(Vs + r0v * 144 + 16 * vt + 4 * p4), trrd(Vs + (r0v + 16) * 144 + 16 * vt + 4 * p4));
            acc1[vt] = MFMA16(af, pb1[a], acc1[vt]); if (BOTH) acc0[vt] = MFMA16(af, pb0[a], acc0[vt]); }
    }
    __builtin_amdgcn_s_setprio(0);
}
__device__ void fox_job(const P& p, int bh, int c, unsigned char* smem) {
    const int tid = lt_tid(), wid = __builtin_amdgcn_readfirstlane(tid >> 6), lane = tid & 63, ln = lane & 15, g = lane >> 4, q4 = (lane >> 2) & 3, p4 = lane & 3;
    const int wq = wid & 3, wk = wid >> 2, b = bh >> 2, h = bh & 3;
    bf16_t* Ks = (bf16_t*)smem;
    bf16_t* Vs = Ks + 2 * 128 * 136;
    float* ck = (float*)(Vs + 2 * 128 * 144);
    const bf16_t* proj = (const bf16_t*)(p.ws + OFF_PROJ); const float* cum = (const float*)(p.ws + OFF_CUM) + bh * LPF;
    const bf16_t* fkp = (const bf16_t*)(p.ws + OFF_FK); const bf16_t* fvp = (const bf16_t*)(p.ws + OFF_FV);
    const int r0 = 128 * c - 112 + 32 * wq;
    const bool val0 = r0 >= 0, val1 = r0 + 16 >= 0;
    const int tq0 = r0 + ln, tq1 = r0 + 16 + ln;
    bf16x8 qf0[4], qf1[4];
    { const bf16_t* q0p = proj + (size_t)rmap(b, max(tq0, 0)) * NPROJ + C_FXQ + h * 128 + 8 * g; const bf16_t* q1p = proj + (size_t)rmap(b, max(tq1, 0)) * NPROJ + C_FXQ + h * 128 + 8 * g;
#pragma unroll
      for (int ks = 0; ks < 4; ++ks) { qf0[ks] = *(const bf16x8*)(q0p + 32 * ks); qf1[ks] = *(const bf16x8*)(q1p + 32 * ks); } }
    const float ct0 = cum[112 + max(tq0, 0)] * LOG2E, ct1 = cum[112 + max(tq1, 0)] * LOG2E;
    f32x4 acc0[8], acc1[8];
#pragma unroll
    for (int vt = 0; vt < 8; ++vt) { acc0[vt] = (f32x4){0.f, 0.f, 0.f, 0.f}; acc1[vt] = (f32x4){0.f, 0.f, 0.f, 0.f}; }
    float m0 = -1e30f, m1 = -1e30f, ls0 = 0.f, ls1 = 0.f;
    const int nkt = 2 * c + 1, nit = c + 1;
    uint4 kr0, kr1, kr2, kr3, vr0, vr1, vr2, vr3; float cr = 0.f;
    const int srow = tid >> 4, sch = tid & 15;
#define FOX_G1(KR, VR, i, lp0) do { const int t_ = min(max((lp0) + srow + 32 * (i) - 112, 0), LT - 1); const size_t o_ = ((size_t)bh * LT + t_) * 128 + sch * 8; \
        KR = *(const uint4*)(fkp + o_); VR = *(const uint4*)(fvp + o_); } while (0)
#define FOX_GLOAD(it_) do { const int lp0_ = 64 * (1 + 2 * (it_)); FOX_G1(kr0, vr0, 0, lp0_); FOX_G1(kr1, vr1, 1, lp0_); FOX_G1(kr2, vr2, 2, lp0_); FOX_G1(kr3, vr3, 3, lp0_); \
        if (tid < 128) cr = -cum[min(lp0_ + tid, LPF - 1)] * LOG2E; } while (0)
#define FOX_S1(KR, VR, i, st_) do { *(uint4*)(Ks + ((st_) * 128 + srow + 32 * (i)) * 136 + sch * 8) = KR; *(uint4*)(Vs + ((st_) * 128 + srow + 32 * (i)) * 144 + sch * 8) = VR; } while (0)
#define FOX_LSTORE(st_) do { FOX_S1(kr0, vr0, 0, st_); FOX_S1(kr1, vr1, 1, st_); FOX_S1(kr2, vr2, 2, st_); FOX_S1(kr3, vr3, 3, st_); if (tid < 128) ck[(st_) * 128 + tid] = cr; } while (0)
    FOX_GLOAD(0); FOX_LSTORE(0);
    __syncthreads();
    for (int it = 0; it < nit; ++it) {
        const int st = it & 1;
        if (it + 1 < nit) FOX_GLOAD(it + 1);
        const int kt = 1 + 2 * it + wk;
        const bool need1 = val1 && kt <= nkt && (64 * kt <= 128 * c + 32 * wq + 31);
        if (need1) {
            const bool need0 = val0 && (64 * kt <= 128 * c + 32 * wq + 15);
            const int rb = st * 128 + wk * 64;
            const int kbase_t = 64 * kt - 112; const float* ckb = ck + st * 128 + wk * 64;
            const bool mask1 = (kt == 1) || (64 * kt + 63 > 128 * c + 32 * wq + 16), mask0 = (kt == 1) || (64 * kt + 63 > 128 * c + 32 * wq);
            if (need0) fox_tile<true>(Ks, Vs, rb, qf0, qf1, acc0, acc1, m0, m1, ls0, ls1, ckb, ct0, ct1, tq0, tq1, kbase_t, mask0, mask1, ln, g, q4, p4);
            else fox_tile<false>(Ks, Vs, rb, qf0, qf1, acc0, acc1, m0, m1, ls0, ls1, ckb, ct0, ct1, tq0, tq1, kbase_t, mask0, mask1, ln, g, q4, p4);
        }
        if (it + 1 < nit) FOX_LSTORE(st ^ 1);
        __syncthreads();
    }
#undef FOX_G1
#undef FOX_GLOAD
#undef FOX_S1
#undef FOX_LSTORE
    float* mg = (float*)smem;
    const int lane_m = lt_tid() & 63;
    if (wk == 1) {
        float* m0p = mg + ((wq * 2 + 0) * 34) * 64 + lane_m; float* m1p = mg + ((wq * 2 + 1) * 34) * 64 + lane_m;
#pragma unroll
        for (int vt = 0; vt < 8; ++vt)
#pragma unroll
            for (int j = 0; j < 4; ++j) { m0p[(vt * 4 + j) * 64] = acc0[vt][j]; m1p[(vt * 4 + j) * 64] = acc1[vt][j]; }
        m0p[32 * 64] = m0; m0p[33 * 64] = ls0; m1p[32 * 64] = m1; m1p[33 * 64] = ls1;
    }
    __syncthreads();
    if (wk == 0) {
#pragma unroll
        for (int sb = 0; sb < 2; ++sb) {
            if (!(sb ? val1 : val0)) continue;
            const float* mp = mg + ((wq * 2 + sb) * 34) * 64 + lane_m;
            const float ma = sb ? m1 : m0, la = sb ? ls1 : ls0, mb = mp[32 * 64], lb = mp[33 * 64];
            const float mt = fmaxf(ma, mb), fa = __builtin_amdgcn_exp2f(ma - mt), fb = __builtin_amdgcn_exp2f(mb - mt);
            float l = la * fa + lb * fb; l += __shfl_xor(l, 16); l += __shfl_xor(l, 32);
            const float inv = 1.f / l;
            int lne = lt_tid() & 15; const int tqe = 128 * c - 112 + 32 * wq + 16 * sb + lne;
            bf16_t* yo = (bf16_t*)(p.ws + OFF_ABUF) + (size_t)rmap(b, tqe) * DM + 1024 + h * 128;
#pragma unroll
            for (int vt = 0; vt < 8; ++vt) { const f32x4 av = sb ? acc1[vt] : acc0[vt]; float o[4];
#pragma unroll
                for (int j = 0; j < 4; ++j) o[j] = (av[j] * fa + mp[(vt * 4 + j) * 64] * fb) * inv;
                uint2 w; w.x = pk2(o[0], o[1]); w.y = pk2(o[2], o[3]); *(uint2*)(yo + 16 * vt + 4 * g) = w; }
        }
    }
    __syncthreads();
}

#define XB_TMO      128
#define XB_XCNT(j)  (256  + 64 * (j))
#define XB_XSUB(j)  (1280 + 64 * (j))
#define XB_XGEN(j)  (2304 + 64 * (j))
#define XB_TOP      3328
#define XB_TOPGEN   3392
#define XCD_BAR_WORDS 3456
#define XB_SPIN_CAP (1u << 18)
#define LAS __attribute__((address_space(3)))

__device__ __forceinline__ unsigned xb_ld(unsigned* p)              { return __hip_atomic_load(p, __ATOMIC_RELAXED, __HIP_MEMORY_SCOPE_AGENT); }
__device__ __forceinline__ unsigned xb_add(unsigned* p, unsigned v) { return __hip_atomic_fetch_add(p, v, __ATOMIC_RELAXED, __HIP_MEMORY_SCOPE_AGENT); }
__device__ __forceinline__ unsigned xb_xcc_id() { return (unsigned)__builtin_amdgcn_s_getreg((3 << 11) | 20) & 0xFu; }
#define XB_SPIN(cond, bar) do { unsigned _sp = 0; while (cond) { __builtin_amdgcn_s_sleep(1); \
    if ((++_sp & 255u) == 0u) { if (xb_ld(&(bar)[XB_TMO])) break; if (_sp > XB_SPIN_CAP) { atomicAdd(&(bar)[XB_TMO], 1u); break; } } } } while (0)

struct XcdBarrier {
    unsigned* bar; unsigned x;
    volatile LAS unsigned* st;
};

__device__ __forceinline__ XcdBarrier xcd_barrier_post(unsigned* bar, volatile LAS unsigned* st) {
    XcdBarrier b; b.bar = bar; b.x = xb_xcc_id(); b.st = st;
    if (threadIdx.x == 0) (void)xb_add(&bar[XB_XCNT(b.x)], 1u);
    return b;
}
__device__ __forceinline__ void xcd_barrier_complete(unsigned* bar, unsigned x, unsigned& nloc, unsigned& nx) {
    const unsigned G = gridDim.x * gridDim.y * gridDim.z;
    unsigned sum, cnt, mine, sp = 0u;
    for (;;) {
        sum = 0u; cnt = 0u; mine = 0u;
#pragma unroll
        for (unsigned j = 0; j < 16; ++j) { const unsigned c = xb_ld(&bar[XB_XCNT(j)]); sum += c; cnt += (c > 0u) ? 1u : 0u; mine = (j == x) ? c : mine; }
        if (sum == G) break;
        __builtin_amdgcn_s_sleep(1);
        if ((++sp & 255u) == 0u) { if (xb_ld(&bar[XB_TMO])) break; if (sp > XB_SPIN_CAP) { atomicAdd(&bar[XB_TMO], 1u); break; } }
    }
    nloc = mine > 0u ? mine : 1u; nx = cnt > 0u ? cnt : 1u;
}

__device__ __forceinline__ void xcd_barrier(const XcdBarrier& b) {
    asm volatile("s_waitcnt vmcnt(0)" ::: "memory");
    __syncthreads();
    if (threadIdx.x == 0) {
        unsigned* bar = b.bar;
        __builtin_amdgcn_s_waitcnt(0);
        unsigned nloc = b.st[0], nx = b.st[1];
        if (nloc == 0u) { xcd_barrier_complete(bar, b.x, nloc, nx); b.st[0] = nloc; b.st[1] = nx; }
        const unsigned old = xb_add(&bar[XB_XSUB(b.x)], 1u);
        const unsigned gen = old / nloc;
        if (old + 1u == (gen + 1u) * nloc) {
            __builtin_amdgcn_fence(__ATOMIC_RELEASE, "agent");
            asm volatile("s_waitcnt vmcnt(0)" ::: "memory");
            const unsigned og = xb_add(&bar[XB_TOP], 1u);
            const unsigned tg = og / nx;
            if (og + 1u == (tg + 1u) * nx) xb_add(&bar[XB_TOPGEN], 1u);
            else XB_SPIN(xb_ld(&bar[XB_TOPGEN]) == tg, bar);
            __builtin_amdgcn_fence(__ATOMIC_ACQUIRE, "agent");
            xb_add(&bar[XB_XGEN(b.x)], 1u);
            asm volatile("s_waitcnt vmcnt(0)" ::: "memory");
        } else {
            XB_SPIN(xb_ld(&bar[XB_XGEN(b.x)]) == gen, bar);
            __builtin_amdgcn_fence(__ATOMIC_ACQUIRE, "agent");
            asm volatile("s_waitcnt vmcnt(0)" ::: "memory");
        }
    }
    __syncthreads();
}


__device__ void phase_m1(const P& p, int l, unsigned char* smem) {
    for (int jb = blockIdx.x; jb < 1586; jb += gridDim.x) {
        if (jb < 16) fox_cum(p, l, jb, smem);
        else if (jb < 544) ml_pass1(p, l, jb - 16, smem);
        else if (jb < 1072) { s5_pass1(p, l, jb - 544, smem); __syncthreads(); }
        else pool_pre(p, jb - 1072);
    }
}
__device__ void phase_m2(const P& p, int l) {
    for (int jb = blockIdx.x; jb < 144; jb += gridDim.x) { if (jb < 128) ml_scan(p, jb); else s5_carry(p, l, jb - 128); }
}
__device__ __forceinline__ void job_publish(unsigned* flag) {
    asm volatile("s_waitcnt vmcnt(0)" ::: "memory");
    __syncthreads();
    if (lt_tid() == 0) { __builtin_amdgcn_fence(__ATOMIC_RELEASE, "agent"); asm volatile("s_waitcnt vmcnt(0)" ::: "memory");
        (void)__hip_atomic_fetch_add(flag, 1u, __ATOMIC_RELAXED, __HIP_MEMORY_SCOPE_AGENT); }
}
__device__ __forceinline__ void job_wait(unsigned* flags, int i, volatile int* s_sat) {
    if (s_sat[i]) return;
    if (lt_tid() == 0) { const unsigned need = i < 16 ? 8u : 4u; unsigned sp = 0u;
        while (__hip_atomic_load(flags + i, __ATOMIC_RELAXED, __HIP_MEMORY_SCOPE_AGENT) < need) { __builtin_amdgcn_s_sleep(4); if (++sp > (1u << 20)) break; } }
    __syncthreads();
    { const int t_ = lt_tid(); if (t_ < 20) s_sat[t_] = __hip_atomic_load(flags + t_, __ATOMIC_RELAXED, __HIP_MEMORY_SCOPE_AGENT) >= (t_ < 16 ? 8u : 4u) ? 1 : 0; }
    __builtin_amdgcn_fence(__ATOMIC_ACQUIRE, "agent");
    asm volatile("s_waitcnt vmcnt(0)" ::: "memory");
    __syncthreads();
}
__device__ void phase_m3(const P& p, int l, unsigned char* smem) {
    __shared__ int s_job; __shared__ int s_sat[20];
    unsigned* ctr = (unsigned*)(p.ws + OFF_CTR) + l * 16;
    unsigned* fml = (unsigned*)(p.ws + OFF_CTR) + 64 + l * 32;
    { const int t_ = lt_tid(); if (t_ < 20) s_sat[t_] = 0; }
    __syncthreads();
    for (;;) {
        if (lt_tid() == 0) s_job = (int)atomicAdd(ctr, 1u);
        __syncthreads();
        const int jb = s_job;
        __syncthreads();
        if (jb >= 1728) break;
        if (jb < 128) { ml_scan(p, jb); job_publish(fml + (jb >> 3)); }
        else if (jb < 144) { s5_carry(p, l, jb - 128); job_publish(fml + 16 + ((jb - 128) >> 2)); }
        else if (jb < 672) { const int k = jb - 144; fox_job(p, k & 15, 32 - (k >> 4), smem); }
        else if (jb < 1200) { const int j = jb - 672; job_wait(fml, j / NCH, s_sat); ml_pass2(p, l, j, smem); }
        else { const int j = jb - 1200; job_wait(fml, 16 + j / 132, s_sat); s5_pass2(p, l, j, smem); __syncthreads(); }
    }
}

__global__ __launch_bounds__(512, 2) void mega(P p, int ph0, int ph1) {
    extern __shared__ __attribute__((aligned(16))) unsigned char smem[];
    cg::grid_group grid = cg::this_grid();
    __shared__ uint4 xb_words;
    if (threadIdx.x == 0) xb_words = make_uint4(0u, 0u, 0u, 0u);
    __syncthreads();
    const XcdBarrier xb = xcd_barrier_post((unsigned*)(p.ws + OFF_XBAR), (volatile LAS unsigned*)&xb_words);
    bf16_t* abuf = (bf16_t*)(p.ws + OFF_ABUF); bf16_t* fbuf = (bf16_t*)(p.ws + OFF_FBUF);
    for (int ph = ph0; ph < ph1; ++ph) {
        if (ph > 0 && (ph - 1) % 10 == 2) continue;
        if (ph > ph0) { if (ph1 < 0) grid.sync(); else xcd_barrier(xb); }
        if (ph == 0) {
            convert_phase(p, 0, smem); row_first(p);
            continue;
        }
        const int l = (ph - 1) / 10, s = (ph - 1) % 10;
        switch (s) {
        case 0: { EpiG1 E; E.O = (bf16_t*)(p.ws + OFF_PROJ); E.gates = (float*)(p.ws + OFF_GATES); E.fk = (bf16_t*)(p.ws + OFF_FK); E.fv = (bf16_t*)(p.ws + OFF_FV); run_gemm(smem, abuf, (const bf16_t*)(p.ws + OFF_WIN), NIN, DM, E, 0); } break;
        case 1: phase_m1(p, l, smem); break;
        case 2: phase_m2(p, l); break;
        case 3: phase_m3(p, l, smem);
                { EpiPool E2; E2.O = abuf; E2.scale = p.in[I_POOLS] + l * 512; run_gemm(smem, (const bf16_t*)(p.ws + OFF_POOLED), (const bf16_t*)(p.ws + OFF_WPOOL), 512, 512, E2, 60, l == DEPTH - 1 ? NMAIN : MP); } break;
        case 4: { EpiGLU E; E.O = abuf; E.bias = p.in[I_GLUB] + l * 1024; run_gemm(smem, (const bf16_t*)(p.ws + OFF_SY), (const bf16_t*)(p.ws + OFF_WGLU), 1024, 512, E, 0, l == DEPTH - 1 ? NMAIN : MP); } break;
        case 5: { EpiB<0> E; E.O = fbuf; E.ldc = DM; run_gemm(smem, abuf, (const bf16_t*)(p.ws + OFF_WOUT), DM, DM, E, 0, NMAIN);
                  if (l < DEPTH - 1) skinny_meta<2>(smem, abuf, (const bf16_t*)(p.ws + OFF_WOUT), DM, DM, fbuf); } break;
        case 6: row_postmix(p, l); break;
        case 7: { EpiB<1> E; E.O = fbuf; E.ldc = DFF; run_gemm(smem, abuf, (const bf16_t*)(p.ws + OFF_W1), DFF, DM, E, 0, NMAIN);
                  if (l < DEPTH - 1) skinny_meta<1>(smem, abuf, (const bf16_t*)(p.ws + OFF_W1), DFF, DM, fbuf); } break;
        case 8: { EpiB<0> E; E.O = abuf; E.ldc = DM; run_gemm(smem, fbuf, (const bf16_t*)(p.ws + OFF_W2), DM, DFF, E, 0, NMAIN);
                  if (l < DEPTH - 1) skinny_meta<2>(smem, fbuf, (const bf16_t*)(p.ws + OFF_W2), DM, DFF, abuf); } break;
        case 9: row_postffn(p, l); if (l + 1 < DEPTH) convert_phase(p, l + 1, smem); break;
        }
    }
}

extern "C" void kernel_launch(void* const* d_in, const int* in_sizes, int n_in, void* d_out, int out_size, void* d_ws, size_t ws_size, hipStream_t stream) {
    constexpr size_t kDynLds = 147456;
    static int grid_blocks = 0;
    if (!grid_blocks) {
        hipFuncSetAttribute((const void*)mega, hipFuncAttributeMaxDynamicSharedMemorySize, (int)kDynLds);
        int dev = 0, cus = 0, per_cu = 0;
        hipGetDevice(&dev);
        hipDeviceGetAttribute(&cus, hipDeviceAttributeMultiprocessorCount, dev);
        hipOccupancyMaxActiveBlocksPerMultiprocessor(&per_cu, mega, 512, kDynLds);
        if (per_cu < 1) per_cu = 1;
        grid_blocks = cus * (per_cu > 1 ? 1 : per_cu);
    }
    P p{};
    for (int i = 0; i < N_IN; ++i) p.in[i] = (const float*)d_in[i];
    p.out = (float*)d_out; p.ws = (unsigned char*)d_ws;
    (void)hipMemsetAsync((unsigned char*)d_ws + OFF_CTR, 0, 512 + 3456 * 4, stream);
    int ph0 = 0, ph1 = 1 + 10 * DEPTH;
    void* args[] = {&p, &ph0, &ph1};
    hipError_t e = hipLaunchCooperativeKernel((const void*)mega, dim3(grid_blocks), dim3(512), args, kDynLds, stream);
    if (e != hipSuccess) fprintf(stderr, "cooperative launch failed: %s (grid %d)\n", hipGetErrorString(e), grid_blocks);
}
```
